# Optimizing an MI355X kernel written in HIP

```python
import jax, jax.numpy as jnp
from jax import lax
import numpy as np

D_MODEL = 1024
BATCH = 8
SEQ = 2048
DEPTH = 2
DEC_BATCH = 128
DEC_SEQ = 4
PAST_LEN = 16384
PAGE_SIZE = 128

D_PLE = 256
EPS = 1e-6
A_GROUPS = 4
D_A = D_MODEL // 2
A_CH = D_A // A_GROUPS
CHUNK = 128
D_B = D_MODEL // 2
CONV_W = 3
C_GROUPS = 4
D_C = D_MODEL // 2
C_CH = D_C // C_GROUPS
POOL_WINDOWS = (2, 4, 8, 16)
MAX_WIN = 16
N_BRANCH = 3
SPLITS = (D_A, 2 * D_A, 2 * D_A + D_B, 2 * D_A + 2 * D_B, 2 * D_A + 3 * D_B, 2 * D_A + 3 * D_B + D_C)
D_IN_TOTAL = 2 * D_A + 3 * D_B + D_C + N_BRANCH * D_MODEL
D_FF = 2816

kernel_name = 'hybrid_chunkmlp_conv_pool_decoder_step'


def rmsnorm(x, g):
    xf = x.astype(jnp.float32)
    y = xf * lax.rsqrt(jnp.mean(xf * xf, axis=-1, keepdims=True) + EPS)
    return (y * g.astype(jnp.float32)).astype(x.dtype)


def layernorm(x, g, b):
    xf = x.astype(jnp.float32)
    mu = jnp.mean(xf, axis=-1, keepdims=True)
    var = jnp.mean(jnp.square(xf - mu), axis=-1, keepdims=True)
    y = (xf - mu) * lax.rsqrt(var + EPS)
    return (y * g.astype(jnp.float32) + b.astype(jnp.float32)).astype(x.dtype)


def swiglu(h, w_up, w_down):
    gate, up = jnp.split(h @ w_up, 2, axis=-1)
    return (jax.nn.silu(gate) * up) @ w_down


def chunk_spatial_gate(u, v, w_s, b_s):
    n, t, _ = v.shape
    n_chunks = -(-t // CHUNK)
    pad = n_chunks * CHUNK - t
    vp = jnp.pad(v, ((0, 0), (0, pad), (0, 0))).reshape(n, n_chunks, CHUNK, A_GROUPS, A_CH)
    mask = jnp.tril(jnp.ones((CHUNK, CHUNK), dtype=bool))
    w = jnp.where(mask[None], w_s, 0.0).astype(v.dtype)
    mixed = jnp.einsum('gts,bnsgc->bntgc', w, vp) + b_s.T[None, None, :, :, None]
    mixed = mixed.reshape(n, n_chunks * CHUNK, D_A)[:, :t]
    return u * mixed


def short_conv(xc, buf, w_conv):
    t = xc.shape[1]
    xp = jnp.concatenate([buf, xc], axis=1)
    y = xp[:, 0:t] * w_conv[0]
    for k in range(1, CONV_W):
        y = y + xp[:, k:k + t] * w_conv[k]
    return y, xp[:, -(CONV_W - 1):]


def multiscale_pool(xq, buf, start):
    t = xq.shape[1]
    lb = MAX_WIN - 1
    xcat = jnp.concatenate([buf, xq], axis=1)
    xf = xcat.astype(jnp.float32)
    cs = jnp.pad(jnp.cumsum(xf, axis=1), ((0, 0), (1, 0), (0, 0)))
    pos = start + jnp.arange(t)
    outs = []
    for gi, win in enumerate(POOL_WINDOWS):
        sl = slice(gi * C_CH, (gi + 1) * C_CH)
        hi = cs[:, lb + 1:lb + 1 + t, sl]
        lo = cs[:, lb + 1 - win:lb + 1 - win + t, sl]
        cnt = jnp.minimum(win, pos + 1).astype(jnp.float32)[None, :, None]
        outs.append((hi - lo) / cnt)
    mean = jnp.concatenate(outs, axis=-1)
    return (mean - xf[:, lb:]).astype(xq.dtype), xcat[:, -lb:]


def trunk_layer(x, p, conv_buf, pool_buf, start, w):
    h = rmsnorm(x, w['g_ffn1'])
    x = x + 0.5 * swiglu(h, w['w_ffn1_up'], w['w_ffn1_down'])
    h = rmsnorm(x, w['g_mix'])
    z = h @ w['w_in']
    u_a, v_a, b_gate, c_gate, x_b, x_c, gates = jnp.split(z, SPLITS, axis=-1)
    u_a = jax.nn.gelu(u_a)
    v_a = layernorm(jax.nn.gelu(v_a), w['a_ln_g'], w['a_ln_b'])
    y_a = chunk_spatial_gate(u_a, v_a, w['a_ws'], w['a_bs']) @ w['a_out']
    conv_out, new_conv = short_conv(c_gate * x_b, conv_buf, w['b_conv'])
    y_b = (b_gate * conv_out) @ w['b_out']
    pooled, new_pool = multiscale_pool(x_c, pool_buf, start)
    n, t, _ = pooled.shape
    pc = jnp.einsum('btgc,gcd->btgd', pooled.reshape(n, t, C_GROUPS, C_CH), w['c_w']).reshape(n, t, D_C)
    y_c = (pc * w['c_scale']) @ w['c_out']
    g = jax.nn.sigmoid(gates).reshape(n, t, N_BRANCH, D_MODEL)
    merged = g[:, :, 0] * y_a + g[:, :, 1] * y_b + g[:, :, 2] * y_c
    x = x + merged @ w['w_o']
    h = rmsnorm(x, w['g_ffn2'])
    x = x + 0.5 * swiglu(h, w['w_ffn2_up'], w['w_ffn2_down'])
    h = rmsnorm(x, w['g_ple'])
    x = x + jax.nn.sigmoid(h @ w['w_ple_gate']) * (p @ w['w_ple_proj'])
    return x, v_a, new_conv, new_pool


def setup_inputs(seed: int = 0) -> dict:
    key = jax.random.key(seed)
    ks = iter(jax.random.split(key, 48))

    def nrm(shape, scale):
        return jax.random.normal(next(ks), shape, jnp.float32) * scale

    def gain(shape):
        return 1.0 + nrm(shape, 0.05)

    L = DEPTH
    return {
        'x_prompt': nrm((BATCH, SEQ, D_MODEL), 1.0),
        'x_sample': nrm((DEC_BATCH, DEC_SEQ, D_MODEL), 1.0),
        'state_conv': nrm((L, DEC_BATCH, CONV_W - 1, D_B), 1.0),
        'state_pool': nrm((L, DEC_BATCH, MAX_WIN - 1, D_C), 1.0),
        'p_prompt': nrm((L, BATCH, SEQ, D_PLE), 1.0),
        'p_sample': nrm((L, DEC_BATCH, DEC_SEQ, D_PLE), 1.0),
        'g_ffn1': gain((L, D_MODEL)),
        'w_ffn1_up': nrm((L, D_MODEL, 2 * D_FF), D_MODEL ** -0.5),
        'w_ffn1_down': nrm((L, D_FF, D_MODEL), D_FF ** -0.5),
        'g_mix': gain((L, D_MODEL)),
        'w_in': nrm((L, D_MODEL, D_IN_TOTAL), D_MODEL ** -0.5),
        'a_ln_g': gain((L, D_A)),
        'a_ln_b': nrm((L, D_A), 0.02),
        'a_ws': nrm((L, A_GROUPS, CHUNK, CHUNK), 0.5 * CHUNK ** -0.5),
        'a_bs': 1.0 + nrm((L, A_GROUPS, CHUNK), 0.1),
        'a_out': nrm((L, D_A, D_MODEL), D_A ** -0.5),
        'b_conv': nrm((L, CONV_W, D_B), CONV_W ** -0.5),
        'b_out': nrm((L, D_B, D_MODEL), D_B ** -0.5),
        'c_w': nrm((L, C_GROUPS, C_CH, C_CH), C_CH ** -0.5),
        'c_scale': 1.0 + nrm((L, D_C), 0.1),
        'c_out': nrm((L, D_C, D_MODEL), D_C ** -0.5),
        'w_o': nrm((L, D_MODEL, D_MODEL), D_MODEL ** -0.5),
        'g_ffn2': gain((L, D_MODEL)),
        'w_ffn2_up': nrm((L, D_MODEL, 2 * D_FF), D_MODEL ** -0.5),
        'w_ffn2_down': nrm((L, D_FF, D_MODEL), D_FF ** -0.5),
        'g_ple': gain((L, D_MODEL)),
        'w_ple_gate': nrm((L, D_MODEL, D_MODEL), D_MODEL ** -0.5),
        'w_ple_proj': nrm((L, D_PLE, D_MODEL), D_PLE ** -0.5),
        'g_final': gain((D_MODEL,)),
    }


def reference(x_prompt, x_sample, state_conv, state_pool, p_prompt, p_sample,
              g_ffn1, w_ffn1_up, w_ffn1_down, g_mix, w_in, a_ln_g, a_ln_b, a_ws, a_bs, a_out,
              b_conv, b_out, c_w, c_scale, c_out, w_o, g_ffn2, w_ffn2_up, w_ffn2_down,
              g_ple, w_ple_gate, w_ple_proj, g_final):
    yp, ys = x_prompt, x_sample
    nb = x_prompt.shape[0]
    conv_p, conv_s, pool_p, pool_s, va_s = [], [], [], [], []
    for i in range(DEPTH):
        w = {
            'g_ffn1': g_ffn1[i], 'w_ffn1_up': w_ffn1_up[i], 'w_ffn1_down': w_ffn1_down[i],
            'g_mix': g_mix[i], 'w_in': w_in[i], 'a_ln_g': a_ln_g[i], 'a_ln_b': a_ln_b[i],
            'a_ws': a_ws[i], 'a_bs': a_bs[i], 'a_out': a_out[i], 'b_conv': b_conv[i], 'b_out': b_out[i],
            'c_w': c_w[i], 'c_scale': c_scale[i], 'c_out': c_out[i], 'w_o': w_o[i],
            'g_ffn2': g_ffn2[i], 'w_ffn2_up': w_ffn2_up[i], 'w_ffn2_down': w_ffn2_down[i],
            'g_ple': g_ple[i], 'w_ple_gate': w_ple_gate[i], 'w_ple_proj': w_ple_proj[i],
        }
        zero_conv = jnp.zeros((nb, CONV_W - 1, D_B), x_prompt.dtype)
        zero_pool = jnp.zeros((nb, MAX_WIN - 1, D_C), x_prompt.dtype)
        yp, _, nc_p, np_p = trunk_layer(yp, p_prompt[i], zero_conv, zero_pool, 0, w)
        ys, v_s, nc_s, np_s = trunk_layer(ys, p_sample[i], state_conv[i], state_pool[i], PAST_LEN, w)
        conv_p.append(nc_p)
        conv_s.append(nc_s)
        pool_p.append(np_p)
        pool_s.append(np_s)
        va_s.append(v_s)
    y_prompt = rmsnorm(yp, g_final)
    y_sample = rmsnorm(ys, g_final)
    return (y_prompt, y_sample, jnp.stack(conv_p), jnp.stack(conv_s), jnp.stack(pool_p), jnp.stack(pool_s), jnp.stack(va_s))
```

```cpp
#include <hip/hip_runtime.h>
#include <hip/hip_cooperative_groups.h>
#include <cstdio>
#include <cstdint>
namespace cg = cooperative_groups;

#define LAS __attribute__((address_space(3)))
typedef unsigned short bf16_t;
typedef short bf16x8 __attribute__((ext_vector_type(8)));
typedef float f32x4 __attribute__((ext_vector_type(4)));
typedef unsigned u32x4 __attribute__((ext_vector_type(4)));

constexpr int MP = 16384, MS = 512, M = MP + MS;
constexpr int D = 1024, FF = 2816, DIN = 6144, DPLE = 256;
constexpr int NMIX = 1536;
constexpr float EPS = 1e-6f;
constexpr int NT = 512;

constexpr size_t O_CONVP = 17301504, O_CONVS = 17317888, O_POOLP = 17580032, O_POOLS = 17702912, O_VAS = 19668992;

constexpr size_t MiB = 1u << 20;
constexpr size_t WS_SS = 0;
constexpr size_t SS_BUF = (size_t)M * 16 * 4;
constexpr size_t WS_WSB = 9 * MiB;
constexpr size_t WS_BAR = 9 * MiB + 512 * 1024;
constexpr size_t WS_W0 = 10 * MiB, WS_W1 = 22 * MiB;
constexpr size_t WS_XB = 34 * MiB;
constexpr size_t WS_MIX = 67 * MiB;
constexpr size_t WS_BIG = 117 * MiB;
constexpr size_t WS_END = WS_BIG + (size_t)M * DIN * 2;
constexpr size_t XBN_OFF = 16 * MiB, PP_OFF = 100 * MiB;
constexpr size_t WA_UP1 = 0, WA_DN1 = 12 * MiB, WA_IN = 18 * MiB, WA_ABC = 30 * MiB, WA_O = 33 * MiB, WA_UP2 = 35 * MiB, WA_DN2 = 47 * MiB, WA_PROJ = 53 * MiB, WA_PG = 54 * MiB;

#ifndef PROBE
#define PROBE 0
#endif
#ifndef PHASE_MASK
#define PHASE_MASK 0xFFFF
#endif
constexpr int RING_BYTES = 131072;
constexpr int LDS_BYTES = 147456;

__device__ __forceinline__ unsigned cvt_pk_bf16(float lo, float hi) { unsigned r; asm volatile("v_cvt_pk_bf16_f32 %0, %1, %2" : "=v"(r) : "v"(lo), "v"(hi)); return r; }
__device__ __forceinline__ float bf_lo(unsigned w) { return __builtin_bit_cast(float, w << 16); }
__device__ __forceinline__ float bf_hi(unsigned w) { return __builtin_bit_cast(float, w & 0xffff0000u); }
struct F8 { f32x4 a, b; };
__device__ __forceinline__ F8 unpack8(u32x4 w) { F8 r; r.a = (f32x4){bf_lo(w.x), bf_hi(w.x), bf_lo(w.y), bf_hi(w.y)}; r.b = (f32x4){bf_lo(w.z), bf_hi(w.z), bf_lo(w.w), bf_hi(w.w)}; return r; }
__device__ __forceinline__ u32x4 pack8(f32x4 a, f32x4 b) { u32x4 w; w.x = cvt_pk_bf16(a[0], a[1]); w.y = cvt_pk_bf16(a[2], a[3]); w.z = cvt_pk_bf16(b[0], b[1]); w.w = cvt_pk_bf16(b[2], b[3]); return w; }
__device__ __forceinline__ F8 ld_bf8(const bf16_t* p) { return unpack8(*(const u32x4*)p); }
__device__ __forceinline__ F8 ld_f8(const float* p) { F8 r; r.a = *(const f32x4*)p; r.b = *(const f32x4*)(p + 4); return r; }
__device__ __forceinline__ float sigmoidf_(float x) { return __builtin_amdgcn_rcpf(1.0f + __builtin_amdgcn_exp2f(-1.4426950408889634f * x)); }
__device__ __forceinline__ float siluf_(float x) { return x * sigmoidf_(x); }
__device__ __forceinline__ float gelu_tanh_(float x) { const float y = 0.7978845608028654f * (x + 0.044715f * x * x * x); return x * sigmoidf_(2.0f * y); }
__device__ __forceinline__ float wave_sum(float v) {
#pragma unroll
    for (int o = 1; o < 64; o <<= 1) v += __shfl_xor(v, o);
    return v;
}
__device__ __forceinline__ float row_rstd(const float* ss, int row) {
    const f32x4* p = (const f32x4*)(ss + (size_t)row * 16);
    const f32x4 a = p[0], b = p[1], c = p[2], d = p[3];
    const f32x4 s = (a + b) + (c + d);
    const float t = (s[0] + s[1]) + (s[2] + s[3]);
    return __builtin_amdgcn_rsqf(t * (1.0f / 1024.0f) + EPS);
}

namespace pg8 {
constexpr int BM = 256, BK = 64, HALF = 128, HTB = HALF * BK * 2, NXCD = 8, WGM = 8;
__host__ __device__ __forceinline__ int lds_byte(int r, int c) { const int st = (r >> 4) * 2 + (c >> 5), rr = r & 15, cc = c & 31, ob = rr * 64 + cc * 2; return st * 1024 + (ob ^ (((ob >> 9) & 1) << 5)); }
__host__ __device__ __forceinline__ void stage_rc(int b, int& R, int& C) { const int st = b / 1024, sb = b % 1024, swz = sb ^ (((sb >> 9) & 1) << 5); R = (st >> 1) * 16 + swz / 64; C = (st & 1) * 32 + (swz % 64) / 2; }
__host__ __device__ __forceinline__ int perm32(int rho) { const int n = rho >> 4, i = rho & 15; return 8 * (i >> 2) + 4 * n + (i & 3); }

struct Unit { int pm, pn, sub; };
struct Gemm { const char* A; const char* Bt; int lda, ldb, K; size_t a_sub, b_sub; };

struct StaticOrder {
    int nM, nN, nwg, G, c, nsub;
    __device__ void init(int M_, int N_, int G_, int c_, int nsub_) { nM = M_ / BM; nN = N_ / BM; nwg = nM * nN; G = G_; c = c_; nsub = nsub_; }
    __device__ bool next(int i, Unit& u) const {
        const int ib = i / nsub; u.sub = i - ib * nsub;
        const long L = (long)ib * G + c; if (L >= nwg) return false;
        int wgid = (int)L; { const int q = nwg / NXCD, r = nwg % NXCD, xcd = wgid % NXCD, off = wgid / NXCD; wgid = (xcd < r ? xcd * (q + 1) : r * (q + 1) + (xcd - r) * q) + off; }
        const int nig = WGM * nN, gid = wgid / nig, fm = gid * WGM, gsz = (nM - fm) < WGM ? (nM - fm) : WGM;
        u.pm = fm + ((wgid % nig) % gsz); u.pn = (wgid % nig) / gsz; return true;
    }
};

template <class Epi, bool HALFN = false>
__device__ __forceinline__ void gemm_phase(LAS unsigned char* lds, const Gemm g, const StaticOrder& S, const Epi& E) {
    int tid = threadIdx.x; asm volatile("" : "+v"(tid));
    const int wid = __builtin_amdgcn_readfirstlane(tid >> 6), lane = tid & 63, wr = wid >> 2, wc = wid & 3, fr = lane & 15, fq = lane >> 4;
    const int K = g.K, nt = K / BK;
    unsigned voffA[2], voffB[2];
#pragma unroll
    for (int i = 0; i < 2; ++i) { int R, C; stage_rc(tid * 16 + i * 8192, R, C); const int Rb = (R & ~31) + perm32(R & 31);
        voffA[i] = (unsigned)(R * g.lda + C) * 2u; voffB[i] = (unsigned)(Rb * g.ldb + C) * 2u; }
    const size_t kstep = (size_t)(BK * 2);
    const size_t hstepA = (size_t)HALF * g.lda * 2, hstepB = (size_t)HALF * g.ldb * 2;
    const size_t tstepA = 2 * hstepA, tstepB = 2 * hstepB;
    const unsigned ldsw = (unsigned)wid * 1024u;
    const int aoff = lds_byte(wr * 64 + fr, fq * 8), boff = lds_byte(wc * 32 + fr, fq * 8);
#define PG8_SA(b, h) (((b) * 2 + (h)) * HTB)
#define PG8_SB(b, h) ((4 + (b) * 2 + (h)) * HTB)
#define PG8_STAGE(bufoff, gbase, voff) do { _Pragma("unroll") for (int _i = 0; _i < 2; ++_i) \
        __builtin_amdgcn_global_load_lds((const unsigned*)((const char*)(gbase) + (voff)[_i]), (LAS unsigned*)(lds + (bufoff) + ldsw + _i * 8192), 16, 0, 0); } while (0)
#define PG8_LDA(dst, b, h) do { _Pragma("unroll") for (int m = 0; m < 4; ++m) _Pragma("unroll") for (int k = 0; k < 2; ++k) dst[m][k] = *(const LAS bf16x8*)(lds + PG8_SA(b, h) + aoff + m * 2048 + k * 1024); } while (0)
#define PG8_LDB(dst, b, h) do { _Pragma("unroll") for (int n = 0; n < 2; ++n) _Pragma("unroll") for (int k = 0; k < 2; ++k) dst[n][k] = *(const LAS bf16x8*)(lds + PG8_SB(b, h) + boff + n * 2048 + k * 1024); } while (0)
#define PG8_MMA(ai, bj, At, Bt) do { __builtin_amdgcn_s_setprio(1); _Pragma("unroll") for (int m = 0; m < 4; ++m) _Pragma("unroll") for (int n = 0; n < 2; ++n) _Pragma("unroll") for (int k = 0; k < 2; ++k) \
        acc[ai][bj][m][n] = __builtin_amdgcn_mfma_f32_16x16x32_bf16(Bt[n][k], At[m][k], acc[ai][bj][m][n], 0, 0, 0); __builtin_amdgcn_s_setprio(0); } while (0)
#define PG8_WAIT_V(n) asm volatile("s_waitcnt vmcnt(" #n ")" ::: "memory")
#define PG8_WAIT_L(n) asm volatile("s_waitcnt lgkmcnt(" #n ")" ::: "memory")
#define PG8_BAR __builtin_amdgcn_s_barrier()
#define PG8_SCHED __builtin_amdgcn_sched_barrier(0)
    Unit cur, nxt; int ui = 0;
    if (!S.next(0, cur)) return;
    f32x4 acc[2][2][4][2];
#pragma unroll
    for (int a = 0; a < 2; ++a)
#pragma unroll
        for (int b = 0; b < 2; ++b)
#pragma unroll
            for (int m = 0; m < 4; ++m)
#pragma unroll
                for (int n = 0; n < 2; ++n) acc[a][b][m][n] = (f32x4){0.f, 0.f, 0.f, 0.f};
    bf16x8 At[4][2], B0[2][2], B1[2][2];
#define PG8_UA(u_) (g.A + (size_t)(u_).pm * tstepA + (size_t)(HALFN ? (u_).sub % 3 : (u_).sub) * g.a_sub)
#define PG8_UB(u_) (g.Bt + (size_t)(u_).pn * tstepB + (HALFN ? (size_t)((u_).sub / 3) * hstepB : (size_t)0) + (size_t)(HALFN ? (u_).sub % 3 : (u_).sub) * g.b_sub)
    const char* cA = PG8_UA(cur); const char* cB = PG8_UB(cur);
    f32x4 msum[2][4][2];
    if constexpr (HALFN) {
#pragma unroll
        for (int a = 0; a < 2; ++a)
#pragma unroll
            for (int m = 0; m < 4; ++m)
#pragma unroll
                for (int n = 0; n < 2; ++n) msum[a][m][n] = (f32x4){0.f, 0.f, 0.f, 0.f};
    }
    PG8_STAGE(PG8_SB(0, 0), cB, voffB); PG8_STAGE(PG8_SB(0, 1), cB + hstepB, voffB); PG8_STAGE(PG8_SA(0, 0), cA, voffA); PG8_STAGE(PG8_SA(0, 1), cA + hstepA, voffA);
    if (wr == 1) PG8_BAR;
    PG8_WAIT_V(2); PG8_BAR;
    PG8_STAGE(PG8_SB(1, 0), cB + kstep, voffB); PG8_STAGE(PG8_SA(1, 0), cA + kstep, voffA); PG8_STAGE(PG8_SB(1, 1), cB + hstepB + kstep, voffB);
    PG8_WAIT_V(6); PG8_BAR;
    for (;;) {
        const bool has_next = S.next(ui + 1, nxt);
        const char* nA = has_next ? PG8_UA(nxt) : cA;
        const char* nB = has_next ? PG8_UB(nxt) : cB;
        for (int t = 0; t < nt; t += 2) {
            const bool last = (t == nt - 2);
            const char* a1 = cA + (size_t)(t + 1) * kstep;
            const char* a2 = last ? nA : cA + (size_t)(t + 2) * kstep; const char* b2 = last ? nB : cB + (size_t)(t + 2) * kstep;
            const char* a3 = a2 + kstep; const char* b3 = b2 + kstep;
            PG8_LDB(B0, 0, 0); if constexpr (!HALFN) PG8_LDB(B1, 0, 1); PG8_SCHED; PG8_LDA(At, 0, 0); PG8_STAGE(PG8_SA(1, 1), a1 + hstepA, voffA);
            PG8_WAIT_V(8); PG8_WAIT_L(0); PG8_BAR; PG8_MMA(0, 0, At, B0); if constexpr (!HALFN) PG8_MMA(0, 1, At, B1); PG8_BAR; PG8_SCHED;
            PG8_LDA(At, 0, 1); PG8_STAGE(PG8_SB(0, 0), b2, voffB); PG8_STAGE(PG8_SB(0, 1), b2 + hstepB, voffB); PG8_STAGE(PG8_SA(0, 0), a2, voffA);
            PG8_WAIT_V(8); PG8_WAIT_L(0); PG8_BAR; PG8_MMA(1, 0, At, B0); if constexpr (!HALFN) PG8_MMA(1, 1, At, B1); PG8_BAR; PG8_SCHED;
            PG8_LDB(B0, 1, 0); if constexpr (!HALFN) PG8_LDB(B1, 1, 1); PG8_SCHED; PG8_LDA(At, 1, 0); PG8_STAGE(PG8_SA(0, 1), a2 + hstepA, voffA);
            PG8_WAIT_V(8); PG8_WAIT_L(0); PG8_BAR; PG8_MMA(0, 0, At, B0); if constexpr (!HALFN) PG8_MMA(0, 1, At, B1); PG8_BAR; PG8_SCHED;
            PG8_LDA(At, 1, 1); PG8_STAGE(PG8_SB(1, 0), b3, voffB); PG8_STAGE(PG8_SB(1, 1), b3 + hstepB, voffB); PG8_STAGE(PG8_SA(1, 0), a3, voffA);
            PG8_WAIT_V(8); PG8_WAIT_L(0); PG8_BAR; PG8_MMA(1, 0, At, B0); if constexpr (!HALFN) PG8_MMA(1, 1, At, B1); PG8_BAR; PG8_SCHED;
        }
        if (wr == 0) PG8_BAR;
        if constexpr (HALFN) E(acc, msum, cur, wr, wc, fr, fq); else E(acc, cur, wr, wc, fr, fq);
        if (!has_next) break;
#pragma unroll
        for (int a = 0; a < 2; ++a)
#pragma unroll
            for (int b = 0; b < 2; ++b)
#pragma unroll
                for (int m = 0; m < 4; ++m)
#pragma unroll
                    for (int n = 0; n < 2; ++n) acc[a][b][m][n] = (f32x4){0.f, 0.f, 0.f, 0.f};
        cur = nxt; cA = nA; cB = nB; ++ui;
        if (wr == 1) PG8_BAR;
    }
    PG8_WAIT_V(0);
    PG8_BAR;
#undef PG8_UA
#undef PG8_UB
#undef PG8_SA
#undef PG8_SB
#undef PG8_STAGE
#undef PG8_LDA
#undef PG8_LDB
#undef PG8_MMA
#undef PG8_WAIT_V
#undef PG8_WAIT_L
#undef PG8_BAR
#undef PG8_SCHED
}
}
using pg8::Unit;

#define EPI_ARGS const f32x4 (&acc)[2][2][4][2], const Unit& u, int wr, int wc, int fr, int fq

constexpr int TBL_OFF = RING_BYTES + 64;
__device__ __forceinline__ const LAS float* fill_rstd_table(LAS unsigned char* lds, const float* ss, int pm, int wr, int wc, int fr, int fq) {
    LAS float* tbl = (LAS float*)(lds + TBL_OFF);
    const int t = (wr * 4 + wc) * 64 + fq * 16 + fr;
    if (t < 256) tbl[t] = row_rstd(ss, pm * 256 + t);
    asm volatile("s_waitcnt lgkmcnt(0)" ::: "memory"); __builtin_amdgcn_s_barrier(); asm volatile("" ::: "memory");
    return tbl;
}
struct EpiSwiglu {
    bf16_t* act; const float* ss; LAS unsigned char* lds;
    __device__ __forceinline__ void operator()(EPI_ARGS) const {
        const LAS float* tbl = fill_rstd_table(lds, ss, u.pm, wr, wc, fr, fq);
        const int row0 = u.pm * 256 + wr * 64 + fr, col0 = u.pn * 128 + wc * 32 + 8 * fq;
#pragma unroll
        for (int ai = 0; ai < 2; ++ai)
#pragma unroll
            for (int m = 0; m < 4; ++m) {
                const int row = row0 + ai * 128 + m * 16; const float rs = tbl[ai * 128 + wr * 64 + m * 16 + fr];
                f32x4 o[2];
#pragma unroll
                for (int n = 0; n < 2; ++n) { const f32x4 gt = acc[ai][0][m][n] * rs, up = acc[ai][1][m][n] * rs;
#pragma unroll
                    for (int j = 0; j < 4; ++j) o[n][j] = siluf_(gt[j]) * up[j]; }
                *(u32x4*)(act + (size_t)row * FF + col0) = pack8(o[0], o[1]);
            }
    }
};
struct EpiResid {
    const bf16_t* xin; bf16_t* xout; float* ss_out; float scale;
    __device__ __forceinline__ void operator()(EPI_ARGS) const {
        const int row0 = u.pm * 256 + wr * 64 + fr, col0 = u.pn * 256 + wc * 32 + 8 * fq;
        u32x4 xr[8][2];
#pragma unroll
        for (int g = 0; g < 8; ++g)
#pragma unroll
            for (int bj = 0; bj < 2; ++bj) xr[g][bj] = *(const u32x4*)(xin + (size_t)(row0 + (g >> 2) * 128 + (g & 3) * 16) * D + col0 + bj * 128);
        asm volatile("" ::: "memory");
#pragma unroll
        for (int ai = 0; ai < 2; ++ai)
#pragma unroll
            for (int m = 0; m < 4; ++m) {
                const int row = row0 + ai * 128 + m * 16; const size_t off = (size_t)row * D + col0; float sq = 0.f;
#pragma unroll
                for (int bj = 0; bj < 2; ++bj) {
                    const F8 xv = unpack8(xr[ai * 4 + m][bj]);
                    const f32x4 x0 = xv.a + acc[ai][bj][m][0] * scale, x1 = xv.b + acc[ai][bj][m][1] * scale;
                    *(u32x4*)(xout + off + bj * 128) = pack8(x0, x1);
                    sq += (x0[0] * x0[0] + x0[1] * x0[1]) + (x0[2] * x0[2] + x0[3] * x0[3]) + (x1[0] * x1[0] + x1[1] * x1[1]) + (x1[2] * x1[2] + x1[3] * x1[3]);
                }
                sq += __shfl_xor(sq, 16); sq += __shfl_xor(sq, 32);
                if (fq == 0) ss_out[(size_t)row * 16 + u.pn * 4 + wc] = sq;
            }
    }
};
struct EpiZin {
    bf16_t* z; const float* ss; LAS unsigned char* lds;
    __device__ __forceinline__ void operator()(EPI_ARGS) const {
        const LAS float* tbl = fill_rstd_table(lds, ss, u.pm, wr, wc, fr, fq);
        const int row0 = u.pm * 256 + wr * 64 + fr, col0 = u.pn * 256 + wc * 32 + 8 * fq;
        const int mode = u.pn < 4 ? 1 : (u.pn < 12 ? 0 : 2);
#pragma unroll
        for (int ai = 0; ai < 2; ++ai)
#pragma unroll
            for (int m = 0; m < 4; ++m) {
                const int row = row0 + ai * 128 + m * 16; const float rs = tbl[ai * 128 + wr * 64 + m * 16 + fr];
#pragma unroll
                for (int bj = 0; bj < 2; ++bj) {
                    f32x4 v0 = acc[ai][bj][m][0] * rs, v1 = acc[ai][bj][m][1] * rs;
                    if (mode == 1) {
#pragma unroll
                        for (int j = 0; j < 4; ++j) { v0[j] = gelu_tanh_(v0[j]); v1[j] = gelu_tanh_(v1[j]); }
                    } else if (mode == 2) {
#pragma unroll
                        for (int j = 0; j < 4; ++j) { v0[j] = sigmoidf_(v0[j]); v1[j] = sigmoidf_(v1[j]); }
                    }
                    *(u32x4*)(z + (size_t)row * DIN + col0 + bj * 128) = pack8(v0, v1);
                }
            }
    }
};
struct EpiMerge {
    unsigned char* zb;
    __device__ __forceinline__ void operator()(EPI_ARGS) const {
        const int row0 = u.pm * 256 + wr * 64 + fr, col0 = u.pn * 256 + wc * 32 + 8 * fq; const int sub = u.sub;
#pragma unroll
        for (int ai = 0; ai < 2; ++ai) {
            u32x4 gt[4][2], pr[4][2];
#pragma unroll
            for (int m = 0; m < 4; ++m) {
                unsigned char* rp = zb + (size_t)(row0 + ai * 128 + m * 16) * (DIN * 2);
#pragma unroll
                for (int bj = 0; bj < 2; ++bj) { const int col = col0 + bj * 128;
                    gt[m][bj] = *(const u32x4*)(rp + (size_t)(3072 + sub * 1024 + col) * 2);
                    if (sub > 0) pr[m][bj] = *(const u32x4*)(rp + (size_t)col * 2); }
            }
            asm volatile("" ::: "memory");
#pragma unroll
            for (int m = 0; m < 4; ++m) {
                unsigned char* rp = zb + (size_t)(row0 + ai * 128 + m * 16) * (DIN * 2);
#pragma unroll
                for (int bj = 0; bj < 2; ++bj) { const int col = col0 + bj * 128;
                    const F8 gv = unpack8(gt[m][bj]);
                    f32x4 v0 = acc[ai][bj][m][0] * gv.a, v1 = acc[ai][bj][m][1] * gv.b;
                    if (sub > 0) { const F8 pv = unpack8(pr[m][bj]); v0 += pv.a; v1 += pv.b; }
                    *(u32x4*)(rp + (size_t)col * 2) = pack8(v0, v1); }
            }
            asm volatile("" ::: "memory");
        }
    }
};
struct EpiMergeH {
    unsigned char* zb;
    __device__ __forceinline__ void operator()(const f32x4 (&acc)[2][2][4][2], f32x4 (&msum)[2][4][2], const Unit& u, int wr, int wc, int fr, int fq) const {
        const int b = u.sub % 3, h = u.sub / 3;
        const int row0 = u.pm * 256 + wr * 64 + fr, col = u.pn * 256 + h * 128 + wc * 32 + 8 * fq;
        u32x4 gt[2][4];
#pragma unroll
        for (int ai = 0; ai < 2; ++ai)
#pragma unroll
            for (int m = 0; m < 4; ++m) gt[ai][m] = *(const u32x4*)(zb + (size_t)(row0 + ai * 128 + m * 16) * (DIN * 2) + (size_t)(3072 + b * 1024 + col) * 2);
#pragma unroll
        for (int ai = 0; ai < 2; ++ai)
#pragma unroll
            for (int m = 0; m < 4; ++m) {
                const F8 gv = unpack8(gt[ai][m]);
                f32x4 v0 = acc[ai][0][m][0] * gv.a, v1 = acc[ai][0][m][1] * gv.b;
                if (b > 0) { v0 += msum[ai][m][0]; v1 += msum[ai][m][1]; }
                if (b < 2) { msum[ai][m][0] = v0; msum[ai][m][1] = v1; }
                else *(u32x4*)(zb + (size_t)(row0 + ai * 128 + m * 16) * (DIN * 2) + (size_t)col * 2) = pack8(v0, v1);
            }
    }
};
struct EpiPP {
    bf16_t* o;
    __device__ __forceinline__ void operator()(EPI_ARGS) const {
        const int row0 = u.pm * 256 + wr * 64 + fr, col0 = u.pn * 256 + wc * 32 + 8 * fq;
#pragma unroll
        for (int ai = 0; ai < 2; ++ai)
#pragma unroll
            for (int m = 0; m < 4; ++m) {
                const int row = row0 + ai * 128 + m * 16;
#pragma unroll
                for (int bj = 0; bj < 2; ++bj) *(u32x4*)(o + (size_t)row * D + col0 + bj * 128) = pack8(acc[ai][bj][m][0], acc[ai][bj][m][1]);
            }
    }
};
struct EpiPle {
    const bf16_t* xin; bf16_t* xout; const bf16_t* pp; const float* ss; float* ss_out; LAS unsigned char* lds;
    __device__ __forceinline__ void operator()(EPI_ARGS) const {
        const LAS float* tbl = fill_rstd_table(lds, ss, u.pm, wr, wc, fr, fq);
        const int row0 = u.pm * 256 + wr * 64 + fr, col0 = u.pn * 256 + wc * 32 + 8 * fq;
#pragma unroll
        for (int ai = 0; ai < 2; ++ai) {
            u32x4 pw[4][2], xw[4][2];
#pragma unroll
            for (int m = 0; m < 4; ++m) {
                const size_t off = (size_t)(row0 + ai * 128 + m * 16) * D + col0;
#pragma unroll
                for (int bj = 0; bj < 2; ++bj) { pw[m][bj] = *(const u32x4*)(pp + off + bj * 128); xw[m][bj] = *(const u32x4*)(xin + off + bj * 128); }
            }
            asm volatile("" ::: "memory");
#pragma unroll
            for (int m = 0; m < 4; ++m) {
                const int row = row0 + ai * 128 + m * 16; const size_t off = (size_t)row * D + col0; const float rs = tbl[ai * 128 + wr * 64 + m * 16 + fr]; float sq = 0.f;
#pragma unroll
                for (int bj = 0; bj < 2; ++bj) {
                    const F8 p = unpack8(pw[m][bj]); const F8 xr = unpack8(xw[m][bj]);
                    f32x4 x0 = xr.a, x1 = xr.b;
                    const f32x4 a0 = acc[ai][bj][m][0] * rs, a1 = acc[ai][bj][m][1] * rs;
#pragma unroll
                    for (int j = 0; j < 4; ++j) { x0[j] += sigmoidf_(a0[j]) * p.a[j]; x1[j] += sigmoidf_(a1[j]) * p.b[j]; }
                    *(u32x4*)(xout + off + bj * 128) = pack8(x0, x1);
                    sq += (x0[0] * x0[0] + x0[1] * x0[1]) + (x0[2] * x0[2] + x0[3] * x0[3]) + (x1[0] * x1[0] + x1[1] * x1[1]) + (x1[2] * x1[2] + x1[3] * x1[3]);
                }
                sq += __shfl_xor(sq, 16); sq += __shfl_xor(sq, 32);
                if (ss_out && fq == 0) ss_out[(size_t)row * 16 + u.pn * 4 + wc] = sq;
            }
            asm volatile("" ::: "memory");
        }
    }
};

__device__ __forceinline__ void convert_item(int MAP, const float* __restrict__ W, int N, const float* __restrict__ gsc, bf16_t* WT, int ldt, int row_off, int it, int lane) {
    const int nblk = N / 64;
    const int kb = it / nblk, nb = it - kb * nblk, n0 = 64 * nb, k0 = 64 * kb;
    int orow0;
    if (MAP == 0) orow0 = row_off + n0;
    else { const int h = n0 < FF ? n0 : n0 - FF; orow0 = (h >> 7) * 256 + (h & 127) + (n0 < FF ? 0 : 128); }
    const float* src = W + (size_t)k0 * N + n0 + lane;
    float v[64];
#pragma unroll
    for (int i = 0; i < 64; ++i) v[i] = src[(size_t)i * N];
    if (gsc) {
#pragma unroll
        for (int i = 0; i < 64; ++i) v[i] *= gsc[k0 + i];
    }
    bf16_t* dst = WT + (size_t)(orow0 + lane) * ldt + k0;
#pragma unroll
    for (int c = 0; c < 8; ++c) { u32x4 o; o.x = cvt_pk_bf16(v[8 * c], v[8 * c + 1]); o.y = cvt_pk_bf16(v[8 * c + 2], v[8 * c + 3]); o.z = cvt_pk_bf16(v[8 * c + 4], v[8 * c + 5]); o.w = cvt_pk_bf16(v[8 * c + 6], v[8 * c + 7]);
        *(u32x4*)(dst + 8 * c) = o; }
}
__device__ __forceinline__ void convert_job(int MAP, const float* __restrict__ W, int K, int N, const float* __restrict__ gsc, bf16_t* WT, int ldt, int row_off, int gw, int ngw, LAS float* scr, int lane) {
    const int items = (K / 64) * (N / 64);
    for (int it = gw; it < items; it += ngw) convert_item(MAP, W, N, gsc, WT, ldt, row_off, it, lane);
}
__device__ __forceinline__ int job_items(int id) {
    switch (id) {
    case 0: case 7: return (D / 64) * (2 * FF / 64);
    case 1: case 8: return (FF / 64) * (D / 64);
    case 2: return (D / 64) * (DIN / 64);
    case 3: case 4: return (512 / 64) * (D / 64);
    case 5: return 1024;
    case 6: case 10: return (D / 64) * (D / 64);
    case 9: return (DPLE / 64) * (D / 64);
    default: return M * DPLE / 8 / 256;
    }
}

#define XB_TMO      128
#define XB_XCNT(j)  (256  + 64 * (j))
#define XB_XSUB(j)  (1280 + 64 * (j))
#define XB_XGEN(j)  (2304 + 64 * (j))
#define XB_TOP      3328
#define XB_TOPGEN   3392
#define XCD_BAR_WORDS 3456
#define XB_SPIN_CAP (1u << 20)
__device__ __forceinline__ unsigned xb_ld(unsigned* p)              { return __hip_atomic_load(p, __ATOMIC_RELAXED, __HIP_MEMORY_SCOPE_AGENT); }
__device__ __forceinline__ unsigned xb_add(unsigned* p, unsigned v) { return __hip_atomic_fetch_add(p, v, __ATOMIC_RELAXED, __HIP_MEMORY_SCOPE_AGENT); }
__device__ __forceinline__ unsigned xb_xcc_id() { return (unsigned)__builtin_amdgcn_s_getreg((3 << 11) | 20) & 0xFu; }
#define XB_SPIN(cond, bar) do { unsigned _sp = 0; while (cond) { __builtin_amdgcn_s_sleep(1); \
    if ((++_sp & 255u) == 0u) { if (xb_ld(&(bar)[XB_TMO])) break; if (_sp > XB_SPIN_CAP) { atomicAdd(&(bar)[XB_TMO], 1u); break; } } } } while (0)
struct XcdBarrier { unsigned* bar; unsigned x; volatile LAS unsigned* st; };
__device__ __forceinline__ XcdBarrier xcd_barrier_post(unsigned* bar, volatile LAS unsigned* st) {
    XcdBarrier b; b.bar = bar; b.x = xb_xcc_id(); b.st = st;
    if (threadIdx.x == 0) (void)xb_add(&bar[XB_XCNT(b.x)], 1u);
    return b;
}
__device__ __forceinline__ void xcd_barrier_complete(unsigned* bar, unsigned x, unsigned& nloc, unsigned& nx) {
    const unsigned G = gridDim.x * gridDim.y * gridDim.z;
    unsigned sum, cnt, mine, sp = 0u;
    for (;;) {
        sum = 0u; cnt = 0u; mine = 0u;
#pragma unroll
        for (unsigned j = 0; j < 16; ++j) { const unsigned c = xb_ld(&bar[XB_XCNT(j)]); sum += c; cnt += (c > 0u) ? 1u : 0u; mine = (j == x) ? c : mine; }
        if (sum == G) break;
        __builtin_amdgcn_s_sleep(1);
        if ((++sp & 255u) == 0u) { if (xb_ld(&bar[XB_TMO])) break; if (sp > XB_SPIN_CAP) { atomicAdd(&bar[XB_TMO], 1u); break; } }
    }
    nloc = mine > 0u ? mine : 1u; nx = cnt > 0u ? cnt : 1u;
}
__device__ __forceinline__ void xcd_barrier(const XcdBarrier& b) {
    asm volatile("s_waitcnt vmcnt(0)" ::: "memory");
    __syncthreads();
    if (threadIdx.x == 0) {
        unsigned* bar = b.bar;
        __builtin_amdgcn_s_waitcnt(0);
        unsigned nloc = b.st[0], nx = b.st[1];
        if (nloc == 0u) { xcd_barrier_complete(bar, b.x, nloc, nx); b.st[0] = nloc; b.st[1] = nx; }
        const unsigned old = xb_add(&bar[XB_XSUB(b.x)], 1u);
        const unsigned gen = old / nloc;
        if (old + 1u == (gen + 1u) * nloc) {
            __builtin_amdgcn_fence(__ATOMIC_RELEASE, "agent");
            asm volatile("s_waitcnt vmcnt(0)" ::: "memory");
            const unsigned og = xb_add(&bar[XB_TOP], 1u);
            const unsigned tg = og / nx;
            if (og + 1u == (tg + 1u) * nx) xb_add(&bar[XB_TOPGEN], 1u);
            else XB_SPIN(xb_ld(&bar[XB_TOPGEN]) == tg, bar);
            __builtin_amdgcn_fence(__ATOMIC_ACQUIRE, "agent");
            xb_add(&bar[XB_XGEN(b.x)], 1u);
            asm volatile("s_waitcnt vmcnt(0)" ::: "memory");
        } else {
            XB_SPIN(xb_ld(&bar[XB_XGEN(b.x)]) == gen, bar);
            __builtin_amdgcn_fence(__ATOMIC_ACQUIRE, "agent");
            asm volatile("s_waitcnt vmcnt(0)" ::: "memory");
        }
    }
    __syncthreads();
}


__device__ __forceinline__ void skinny_phase(int kind, LAS unsigned char* lds, const char* gA, const char* gB, int lda, int ldb, int K, size_t asub, size_t bsub,
                                             void* e0, void* e1, const float* e2, float* e3, float scale, const bf16_t* ppb, const bf16_t* z, int G) {
    int tid = threadIdx.x; asm volatile("" : "+v"(tid));
    const int wave = __builtin_amdgcn_readfirstlane(tid >> 6), lane = tid & 63, fr = lane & 15, fq = lane >> 4;
    LAS float* red = (LAS float*)lds;
    const int ng = K >> 6, n = ng > wave ? (ng - wave + 7) >> 3 : 0, nb = kind == 4 ? 3 : 1;
    const int orow = tid >> 4, oc4 = (tid & 15) * 4;
    for (int piece = blockIdx.x; piece < 256; piece += G) {
        const int rg = piece >> 4, cg = piece & 15, row0 = MP + rg * 32, row = row0 + orow, col = cg * 64 + oc4;
        f32x4 msum = (f32x4){0.f, 0.f, 0.f, 0.f};
        for (int b = 0; b < nb; ++b) {
            const bf16_t* ap = (const bf16_t*)(gA + (size_t)b * asub) + (size_t)(row0 + fr) * lda + wave * 64 + fq * 8;
            const bf16_t* bp = (const bf16_t*)(gB + (size_t)b * bsub) + (size_t)(cg * 64 + fr) * ldb + wave * 64 + fq * 8;
            f32x4 acc[2][4];
#pragma unroll
            for (int rb = 0; rb < 2; ++rb)
#pragma unroll
                for (int cb = 0; cb < 4; ++cb) acc[rb][cb] = (f32x4){0.f, 0.f, 0.f, 0.f};
            bf16x8 av[2][2][2], bv[2][2][4];
#define SK_G(dst, ptr) asm volatile("global_load_dwordx4 %0, %1, off" : "=v"(dst) : "v"(ptr) : "memory")
#define SK_LD(buf, i) do { _Pragma("unroll") for (int h = 0; h < 2; ++h) { \
        _Pragma("unroll") for (int rb = 0; rb < 2; ++rb) SK_G(av[buf][h][rb], ap + (size_t)(rb * 16) * lda + (i) * 512 + h * 32); \
        _Pragma("unroll") for (int cb = 0; cb < 4; ++cb) SK_G(bv[buf][h][cb], bp + (size_t)(cb * 16) * ldb + (i) * 512 + h * 32); } } while (0)
#define SK_WAIT(buf, N) asm volatile("s_waitcnt vmcnt(" #N ")" : "+v"(av[buf][0][0]), "+v"(av[buf][0][1]), "+v"(av[buf][1][0]), "+v"(av[buf][1][1]), \
        "+v"(bv[buf][0][0]), "+v"(bv[buf][0][1]), "+v"(bv[buf][0][2]), "+v"(bv[buf][0][3]), "+v"(bv[buf][1][0]), "+v"(bv[buf][1][1]), "+v"(bv[buf][1][2]), "+v"(bv[buf][1][3]) :: "memory")
#define SK_MM(buf) do { _Pragma("unroll") for (int h = 0; h < 2; ++h) _Pragma("unroll") for (int rb = 0; rb < 2; ++rb) _Pragma("unroll") for (int cb = 0; cb < 4; ++cb) \
        acc[rb][cb] = __builtin_amdgcn_mfma_f32_16x16x32_bf16(av[buf][h][rb], bv[buf][h][cb], acc[rb][cb], 0, 0, 0); } while (0)
            asm volatile("s_waitcnt vmcnt(0)" ::: "memory");
            if (n > 0) SK_LD(0, 0);
            int i = 0;
            for (; i + 1 < n; i += 2) {
                SK_LD(1, i + 1);
                SK_WAIT(0, 12); SK_MM(0);
                SK_LD(0, (i + 2 < n ? i + 2 : n - 1));
                SK_WAIT(1, 12); SK_MM(1);
            }
            if (n > 0) { SK_WAIT(0, 0); if (i < n) SK_MM(0); }
#undef SK_G
#undef SK_LD
#undef SK_WAIT
#undef SK_MM
#pragma unroll
            for (int rb = 0; rb < 2; ++rb)
#pragma unroll
                for (int cb = 0; cb < 4; ++cb)
#pragma unroll
                    for (int j = 0; j < 4; ++j) red[(wave * 32 + rb * 16 + fq * 4 + j) * 64 + cb * 16 + fr] = acc[rb][cb][j];
            __syncthreads();
            f32x4 v = *(const LAS f32x4*)(red + orow * 64 + oc4);
#pragma unroll
            for (int w = 1; w < 8; ++w) v += *(const LAS f32x4*)(red + (w * 32 + orow) * 64 + oc4);
            if (kind == 4) {
                const unsigned long long gw_ = *(const unsigned long long*)(z + (size_t)row * DIN + 3072 + b * 1024 + col);
                const unsigned lo = (unsigned)gw_, hi = (unsigned)(gw_ >> 32);
                msum += v * (f32x4){bf_lo(lo), bf_hi(lo), bf_lo(hi), bf_hi(hi)};
            } else msum = v;
            __syncthreads();
        }
        if (kind == 4) {
            *(unsigned long long*)((bf16_t*)e0 + (size_t)row * DIN + col) = (unsigned long long)cvt_pk_bf16(msum[0], msum[1]) | ((unsigned long long)cvt_pk_bf16(msum[2], msum[3]) << 32);
        } else if (kind == 5) {
            *(unsigned long long*)((bf16_t*)e0 + (size_t)row * D + col) = (unsigned long long)cvt_pk_bf16(msum[0], msum[1]) | ((unsigned long long)cvt_pk_bf16(msum[2], msum[3]) << 32);
        } else {
            const bf16_t* xi = (const bf16_t*)e0; bf16_t* xo = (bf16_t*)e1; const size_t off = (size_t)row * D + col;
            const unsigned long long xw = *(const unsigned long long*)(xi + off); const unsigned lo = (unsigned)xw, hi = (unsigned)(xw >> 32);
            f32x4 x = (f32x4){bf_lo(lo), bf_hi(lo), bf_lo(hi), bf_hi(hi)};
            if (kind == 1) x += msum * scale;
            else {
                const float rs = row_rstd(e2, row);
                const unsigned long long pw = *(const unsigned long long*)(ppb + off); const unsigned pl = (unsigned)pw, ph = (unsigned)(pw >> 32);
                const f32x4 p = (f32x4){bf_lo(pl), bf_hi(pl), bf_lo(ph), bf_hi(ph)};
#pragma unroll
                for (int j = 0; j < 4; ++j) x[j] += sigmoidf_(rs * msum[j]) * p[j];
            }
            *(unsigned long long*)(xo + off) = (unsigned long long)cvt_pk_bf16(x[0], x[1]) | ((unsigned long long)cvt_pk_bf16(x[2], x[3]) << 32);
            float sq = (x[0] * x[0] + x[1] * x[1]) + (x[2] * x[2] + x[3] * x[3]);
            sq += __shfl_xor(sq, 1); sq += __shfl_xor(sq, 2); sq += __shfl_xor(sq, 4); sq += __shfl_xor(sq, 8);
            if (e3 && (tid & 15) == 0) e3[(size_t)row * 16 + cg] = sq;
        }
    }
}

struct KArgs { const float* in[29]; float* out; unsigned char* ws; };
enum { I_XP = 0, I_XS, I_SCONV, I_SPOOL, I_PP, I_PS, I_GFFN1, I_WUP1, I_WDN1, I_GMIX, I_WIN, I_LNG, I_LNB, I_AWS, I_ABS, I_AOUT, I_BCONV, I_BOUT, I_CW, I_CSCALE, I_COUT, I_WO,
       I_GFFN2, I_WUP2, I_WDN2, I_GPLE, I_WPG, I_WPP, I_GFINAL };

__device__ __forceinline__ void mixer_a(const KArgs& a, int l, LAS unsigned char* lds, const bf16_t* z, bf16_t* mix, const bf16_t* wsb, int G) {
    int tid = threadIdx.x; asm volatile("" : "+v"(tid));
    const int wid = __builtin_amdgcn_readfirstlane(tid >> 6), lane = tid & 63, fr = lane & 15, fq = lane >> 4;
    LAS bf16_t* ldsV = (LAS bf16_t*)lds;
    LAS float* stats = (LAS float*)(lds + 40960);
    const float* lng = a.in[I_LNG] + l * 512; const float* lnb = a.in[I_LNB] + l * 512; const float* abs_ = a.in[I_ABS] + l * 512;
    {
        float* vout = a.out + O_VAS + (size_t)l * 128 * 4 * 512;
        const float* aws = a.in[I_AWS] + (size_t)l * 4 * 128 * 128;
        const int ch = lane * 8, g = lane >> 4;
        for (int sq = blockIdx.x * 8 + wid; sq < 128; sq += G * 8) {
            const int row0 = MP + sq * 4;
            u32x4 raw[4], uraw[4];
#pragma unroll
            for (int t = 0; t < 4; ++t) { raw[t] = *(const u32x4*)(z + (size_t)(row0 + t) * DIN + 512 + ch); uraw[t] = *(const u32x4*)(z + (size_t)(row0 + t) * DIN + ch); }
            const F8 gg = ld_f8(lng + ch), bb = ld_f8(lnb + ch);
            F8 vn[4];
#pragma unroll
            for (int t = 0; t < 4; ++t) {
                const F8 v = unpack8(raw[t]);
                float s = (v.a[0] + v.a[1]) + (v.a[2] + v.a[3]) + (v.b[0] + v.b[1]) + (v.b[2] + v.b[3]);
                float q = (v.a[0] * v.a[0] + v.a[1] * v.a[1]) + (v.a[2] * v.a[2] + v.a[3] * v.a[3]) + (v.b[0] * v.b[0] + v.b[1] * v.b[1]) + (v.b[2] * v.b[2] + v.b[3] * v.b[3]);
                s = wave_sum(s); q = wave_sum(q);
                const float mu = s * (1.0f / 512.0f), var = q * (1.0f / 512.0f) - mu * mu, rs = __builtin_amdgcn_rsqf(fmaxf(var, 0.f) + EPS);
                vn[t].a = (v.a - mu) * rs * gg.a + bb.a; vn[t].b = (v.b - mu) * rs * gg.b + bb.b;
                float* vo = vout + (size_t)(sq * 4 + t) * 512 + ch; *(f32x4*)vo = vn[t].a; *(f32x4*)(vo + 4) = vn[t].b;
            }
#pragma unroll
            for (int t = 0; t < 4; ++t) {
                const float bs = abs_[g * 128 + t];
                f32x4 m0 = (f32x4){bs, bs, bs, bs}, m1 = m0;
#pragma unroll
                for (int s_ = 0; s_ <= t; ++s_) { const float w = aws[(size_t)(g * 128 + t) * 128 + s_]; m0 += vn[s_].a * w; m1 += vn[s_].b * w; }
                const F8 uu = unpack8(uraw[t]);
                *(u32x4*)(mix + (size_t)(row0 + t) * NMIX + ch) = pack8(uu.a * m0, uu.b * m1);
            }
        }
    }
    for (int un = blockIdx.x; un < 512; un += G) {
        const int g = un & 3, cid = un >> 2, row0 = cid * 128;
        {
            u32x4 raw[16];
#pragma unroll
            for (int i = 0; i < 16; ++i) raw[i] = *(const u32x4*)(z + (size_t)(row0 + wid * 16 + i) * DIN + 512 + lane * 8);
#pragma unroll
            for (int i = 0; i < 16; ++i) {
                const int r = wid * 16 + i; const F8 v = unpack8(raw[i]);
                float s = (v.a[0] + v.a[1]) + (v.a[2] + v.a[3]) + (v.b[0] + v.b[1]) + (v.b[2] + v.b[3]);
                float q = (v.a[0] * v.a[0] + v.a[1] * v.a[1]) + (v.a[2] * v.a[2] + v.a[3] * v.a[3]) + (v.b[0] * v.b[0] + v.b[1] * v.b[1]) + (v.b[2] * v.b[2] + v.b[3] * v.b[3]);
                s = wave_sum(s); q = wave_sum(q);
                const float mu = s * (1.0f / 512.0f), var = q * (1.0f / 512.0f) - mu * mu;
                if (lane == 0) { stats[2 * r] = mu; stats[2 * r + 1] = __builtin_amdgcn_rsqf(fmaxf(var, 0.f) + EPS); }
            }
        }
        __syncthreads();
#pragma unroll
        for (int it = 0; it < 4; ++it) {
            const int item = it * NT + tid, r = item >> 4, seg = item & 15, ch = g * 128 + seg * 8;
            const F8 v = ld_bf8(z + (size_t)(row0 + r) * DIN + 512 + ch);
            const float mu = stats[2 * r], rs = stats[2 * r + 1];
            const F8 gg = ld_f8(lng + ch), bb = ld_f8(lnb + ch);
            const u32x4 w = pack8((v.a - mu) * rs * gg.a + bb.a, (v.b - mu) * rs * gg.b + bb.b);
            LAS bf16_t* dst = ldsV + (seg * 8) * 136 + r;
            dst[0 * 136] = (bf16_t)(w.x & 0xffffu); dst[1 * 136] = (bf16_t)(w.x >> 16); dst[2 * 136] = (bf16_t)(w.y & 0xffffu); dst[3 * 136] = (bf16_t)(w.y >> 16);
            dst[4 * 136] = (bf16_t)(w.z & 0xffffu); dst[5 * 136] = (bf16_t)(w.z >> 16); dst[6 * 136] = (bf16_t)(w.w & 0xffffu); dst[7 * 136] = (bf16_t)(w.w >> 16);
        }
        const int t0 = wid * 16, ksteps = (t0 + 16 + 31) >> 5;
        bf16x8 wv[4];
        const bf16_t* wrow = wsb + ((size_t)(l * 4 + g) * 128 + t0 + fr) * 128 + fq * 8;
#pragma unroll
        for (int k = 0; k < 4; ++k) wv[k] = *(const bf16x8*)(wrow + (k < ksteps ? k : 0) * 32);
        const int trow = row0 + t0 + fr;
        unsigned long long uw[8];
#pragma unroll
        for (int cb = 0; cb < 8; ++cb) uw[cb] = *(const unsigned long long*)(z + (size_t)trow * DIN + g * 128 + cb * 16 + fq * 4);
        const float bs = abs_[g * 128 + t0 + fr];
        __syncthreads();
        f32x4 acc[8];
#pragma unroll
        for (int cb = 0; cb < 8; ++cb) acc[cb] = (f32x4){0.f, 0.f, 0.f, 0.f};
#pragma unroll
        for (int k = 0; k < 4; ++k) {
            if (k < ksteps) {
#pragma unroll
                for (int cb = 0; cb < 8; ++cb) {
                    const bf16x8 vv = *(const LAS bf16x8*)(ldsV + (cb * 16 + fr) * 136 + k * 32 + fq * 8);
                    acc[cb] = __builtin_amdgcn_mfma_f32_16x16x32_bf16(vv, wv[k], acc[cb], 0, 0, 0);
                }
            }
        }
#pragma unroll
        for (int cb = 0; cb < 8; ++cb) {
            const unsigned lo = (unsigned)uw[cb], hi = (unsigned)(uw[cb] >> 32);
            const unsigned o0 = cvt_pk_bf16(bf_lo(lo) * (acc[cb][0] + bs), bf_hi(lo) * (acc[cb][1] + bs)), o1 = cvt_pk_bf16(bf_lo(hi) * (acc[cb][2] + bs), bf_hi(hi) * (acc[cb][3] + bs));
            *(unsigned long long*)(mix + (size_t)trow * NMIX + g * 128 + cb * 16 + fq * 4) = (unsigned long long)o0 | ((unsigned long long)o1 << 32);
        }
        __syncthreads();
    }
}

__device__ __forceinline__ void mixer_bc(const KArgs& a, int l, const bf16_t* z, bf16_t* mix, int G) {
    const float* sconv = a.in[I_SCONV] + (size_t)l * 128 * 2 * 512;
    const float* spool = a.in[I_SPOOL] + (size_t)l * 128 * 15 * 512;
    const float* bconv = a.in[I_BCONV] + l * 3 * 512;
    float* oconvp = a.out + O_CONVP + (size_t)l * 8 * 2 * 512;
    float* oconvs = a.out + O_CONVS + (size_t)l * 128 * 2 * 512;
    float* opoolp = a.out + O_POOLP + (size_t)l * 8 * 15 * 512;
    float* opools = a.out + O_POOLS + (size_t)l * 128 * 15 * 512;
    int tid = threadIdx.x; asm volatile("" : "+v"(tid));
    for (int idx = blockIdx.x * NT + tid; idx < (MP / 2) * 64; idx += G * NT) {
        const int m = (idx >> 6) * 2, seg = idx & 63, ch = seg * 8;
        const bf16_t* zr = z + (size_t)m * DIN;
        const int gi = seg >> 4, win = 2 << gi;
        const F8 w0 = ld_f8(bconv + ch), w1 = ld_f8(bconv + 512 + ch), w2 = ld_f8(bconv + 1024 + ch);
        const int sq = m >> 11, t0 = m & 2047;
        const float k2 = t0 >= 2 ? 1.f : 0.f;
        const bf16_t* zm1 = t0 >= 2 ? zr - DIN : zr; const bf16_t* zm2 = t0 >= 2 ? zr - 2 * DIN : zr;
        const F8 gA_ = ld_bf8(zm2 + 1536 + ch), xA_ = ld_bf8(zm2 + 2048 + ch), gB_ = ld_bf8(zm1 + 1536 + ch), xB_ = ld_bf8(zm1 + 2048 + ch);
        const F8 gC_ = ld_bf8(zr + 1536 + ch), xC_ = ld_bf8(zr + 2048 + ch), gD_ = ld_bf8(zr + DIN + 1536 + ch), xD_ = ld_bf8(zr + DIN + 2048 + ch);
        const F8 bg0 = ld_bf8(zr + 1024 + ch), bg1 = ld_bf8(zr + DIN + 1024 + ch);
        F8 r[17];
#pragma unroll
        for (int k = 0; k < 17; ++k) { const bool ok = (k <= win) && (k <= t0 + 1); r[k] = ld_bf8((ok ? zr + DIN - (size_t)k * DIN : zr) + 2560 + ch); }
        const f32x4 cAa = gA_.a * xA_.a * k2, cAb = gA_.b * xA_.b * k2, cBa = gB_.a * xB_.a * k2, cBb = gB_.b * xB_.b * k2;
        const f32x4 cCa = gC_.a * xC_.a, cCb = gC_.b * xC_.b, cDa = gD_.a * xD_.a, cDb = gD_.b * xD_.b;
        *(u32x4*)(mix + (size_t)m * NMIX + 512 + ch) = pack8(bg0.a * (cAa * w0.a + cBa * w1.a + cCa * w2.a), bg0.b * (cAb * w0.b + cBb * w1.b + cCb * w2.b));
        *(u32x4*)(mix + (size_t)(m + 1) * NMIX + 512 + ch) = pack8(bg1.a * (cBa * w0.a + cCa * w1.a + cDa * w2.a), bg1.b * (cBb * w0.b + cCb * w1.b + cDb * w2.b));
        if (t0 == 2046) { float* o = oconvp + (size_t)(sq * 2) * 512 + ch; *(f32x4*)o = cCa; *(f32x4*)(o + 4) = cCb; *(f32x4*)(o + 512) = cDa; *(f32x4*)(o + 516) = cDb; }
        f32x4 s1a = r[0].a, s1b = r[0].b, s0a = r[1].a, s0b = r[1].b;
#pragma unroll
        for (int k = 1; k < 17; ++k) {
            const float wt1 = (k < win && k <= t0 + 1) ? 1.f : 0.f, wt0 = (k >= 2 && k <= win && k - 1 <= t0) ? 1.f : 0.f;
            s1a += r[k].a * wt1; s1b += r[k].b * wt1; s0a += r[k].a * wt0; s0b += r[k].b * wt0;
        }
        const float inv0 = 1.0f / (float)(win < t0 + 1 ? win : t0 + 1), inv1 = 1.0f / (float)(win < t0 + 2 ? win : t0 + 2);
        *(u32x4*)(mix + (size_t)m * NMIX + 1024 + ch) = pack8(s0a * inv0 - r[1].a, s0b * inv0 - r[1].b);
        *(u32x4*)(mix + (size_t)(m + 1) * NMIX + 1024 + ch) = pack8(s1a * inv1 - r[0].a, s1b * inv1 - r[0].b);
        if (t0 + 1 >= 2033) {
            if (t0 >= 2033) { float* o = opoolp + (size_t)(sq * 15 + (t0 - 2033)) * 512 + ch; *(f32x4*)o = r[1].a; *(f32x4*)(o + 4) = r[1].b; }
            float* o = opoolp + (size_t)(sq * 15 + (t0 + 1 - 2033)) * 512 + ch; *(f32x4*)o = r[0].a; *(f32x4*)(o + 4) = r[0].b;
        }
    }
    for (int idx = blockIdx.x * NT + tid; idx < MS * 64; idx += G * NT) {
        const int m = MP + (idx >> 6), seg = idx & 63, ch = seg * 8;
        const bf16_t* zr = z + (size_t)m * DIN;
        const int gi = seg >> 4, win = 2 << gi;
        const F8 w0 = ld_f8(bconv + ch), w1 = ld_f8(bconv + 512 + ch), w2 = ld_f8(bconv + 1024 + ch);
        {
            const int sq = (m - MP) >> 2, t = (m - MP) & 3;
            F8 c2, c1, c0;
            { const F8 cg_ = ld_bf8(zr + 1536 + ch), xb_ = ld_bf8(zr + 2048 + ch); c2.a = cg_.a * xb_.a; c2.b = cg_.b * xb_.b; }
            if (t >= 1) { const F8 cg_ = ld_bf8(zr - DIN + 1536 + ch), xb_ = ld_bf8(zr - DIN + 2048 + ch); c1.a = cg_.a * xb_.a; c1.b = cg_.b * xb_.b; }
            else c1 = ld_f8(sconv + (size_t)(sq * 2 + 1) * 512 + ch);
            if (t >= 2) { const F8 cg_ = ld_bf8(zr - 2 * DIN + 1536 + ch), xb_ = ld_bf8(zr - 2 * DIN + 2048 + ch); c0.a = cg_.a * xb_.a; c0.b = cg_.b * xb_.b; }
            else c0 = ld_f8(sconv + (size_t)(sq * 2 + t) * 512 + ch);
            {
                const F8 bg = ld_bf8(zr + 1024 + ch);
                const f32x4 ya = bg.a * (c0.a * w0.a + c1.a * w1.a + c2.a * w2.a), yb = bg.b * (c0.b * w0.b + c1.b * w1.b + c2.b * w2.b);
                *(u32x4*)(mix + (size_t)m * NMIX + 512 + ch) = pack8(ya, yb);
            }
            if (t >= 2) { float* o = oconvs + (size_t)(sq * 2 + (t - 2)) * 512 + ch; *(f32x4*)o = c2.a; *(f32x4*)(o + 4) = c2.b; }
            const F8 xt = ld_bf8(zr + 2560 + ch);
            f32x4 s0 = xt.a, s1 = xt.b;
            for (int i = 1; i < win; ++i) {
                const int tp = t - i;
                if (tp >= 0) { const F8 v = ld_bf8(zr - (size_t)i * DIN + 2560 + ch); s0 += v.a; s1 += v.b; }
                else { const F8 v = ld_f8(spool + (size_t)(sq * 15 + 15 + tp) * 512 + ch); s0 += v.a; s1 += v.b; }
            }
            const float inv = 1.0f / (float)win;
            *(u32x4*)(mix + (size_t)m * NMIX + 1024 + ch) = pack8(s0 * inv - xt.a, s1 * inv - xt.b);
            float* o = opools + (size_t)(sq * 15 + 11 + t) * 512 + ch; *(f32x4*)o = xt.a; *(f32x4*)(o + 4) = xt.b;
            if (t == 0) {
                for (int j = 0; j < 11; ++j) { const F8 v = ld_f8(spool + (size_t)(sq * 15 + j + 4) * 512 + ch); float* oj = opools + (size_t)(sq * 15 + j) * 512 + ch; *(f32x4*)oj = v.a; *(f32x4*)(oj + 4) = v.b; }
            }
        }
    }
}

__global__ void __launch_bounds__(NT, 2) fwd_kernel(KArgs a) {
    extern __shared__ __attribute__((aligned(16))) unsigned char lds_raw[];
    LAS unsigned char* lds = (LAS unsigned char*)lds_raw;
    cg::grid_group grid = cg::this_grid();
    const int G = gridDim.x, bx = blockIdx.x;
    const int ngw = G * 8, ngt = G * NT;
    unsigned char* ws = a.ws;
    float* xf = a.out;
    float* ssb = (float*)(ws + WS_SS);
    bf16_t* wsb = (bf16_t*)(ws + WS_WSB);
    unsigned char* wa = (unsigned char*)a.out;
    bf16_t* xb = (bf16_t*)(ws + WS_XB);
    bf16_t* mix = (bf16_t*)(ws + WS_MIX);
    bf16_t* pb = (bf16_t*)(ws + WS_MIX);
    bf16_t* xbn = (bf16_t*)(ws + WS_MIX + XBN_OFF);
    bf16_t* big = (bf16_t*)(ws + WS_BIG);
    bf16_t* ppb = (bf16_t*)(ws + WS_BIG + PP_OFF);
#define SSB(l, i) (ssb + (size_t)((l) * 4 + (i)) * (M * 16))

    if (PHASE_MASK & 1) {
    int tid_o = threadIdx.x; asm volatile("" : "+v"(tid_o));
    const int lane = tid_o & 63, wave = __builtin_amdgcn_readfirstlane(tid_o >> 6);
    const int gw = bx * 8 + wave, gt = bx * NT + tid_o;
    LAS float* scr = (LAS float*)(lds + wave * 16384);
    for (int m0 = gw; m0 < M; m0 += 3 * ngw) {
        f32x4 v[3][4]; float s[3];
#pragma unroll
        for (int r = 0; r < 3; ++r) {
            const int m = (m0 + r * ngw) < M ? m0 + r * ngw : m0;
            const float* src = m < MP ? a.in[I_XP] + (size_t)m * D : a.in[I_XS] + (size_t)(m - MP) * D;
#pragma unroll
            for (int j = 0; j < 4; ++j) v[r][j] = *(const f32x4*)(src + j * 256 + lane * 4);
        }
#pragma unroll
        for (int r = 0; r < 3; ++r) {
            float t = 0.f;
#pragma unroll
            for (int j = 0; j < 4; ++j) t += (v[r][j][0] * v[r][j][0] + v[r][j][1] * v[r][j][1]) + (v[r][j][2] * v[r][j][2] + v[r][j][3] * v[r][j][3]);
            s[r] = wave_sum(t);
        }
#pragma unroll
        for (int r = 0; r < 3; ++r) {
            const int m = m0 + r * ngw;
            if (m < M) {
#pragma unroll
                for (int j = 0; j < 4; ++j)
                    *(unsigned long long*)(xb + (size_t)m * D + j * 256 + lane * 4) = (unsigned long long)cvt_pk_bf16(v[r][j][0], v[r][j][1]) | ((unsigned long long)cvt_pk_bf16(v[r][j][2], v[r][j][3]) << 32);
                if (lane < 16) SSB(0, 0)[(size_t)m * 16 + lane] = lane == 0 ? s[r] : 0.f;
            }
        }
    }
    for (int i = gt; i < 2 * 4 * 128 * 128; i += ngt) { const int tt = (i >> 7) & 127, s_ = i & 127; const float v = a.in[I_AWS][i]; wsb[i] = (bf16_t)(cvt_pk_bf16(s_ <= tt ? v : 0.f, 0.f) & 0xffffu); }
    convert_job(1, a.in[I_WUP1], D, 2 * FF, a.in[I_GFFN1], (bf16_t*)(wa + WA_UP1), D, 0, gw, ngw, scr, lane);
    }
    volatile LAS unsigned* bst = (volatile LAS unsigned*)(lds + RING_BYTES);
    if (threadIdx.x == 0) { bst[0] = 0u; bst[1] = 0u; }
    const XcdBarrier xbar = xcd_barrier_post((unsigned*)(ws + WS_BAR), bst);
    if (ws == nullptr) grid.sync();

#pragma unroll 1
    for (int st = 0; st <= 20; ++st) {
        const int l = st >= 10 ? 1 : 0, s = st - 10 * l;
        if (s != 8) { xcd_barrier(xbar); if (PROBE == 4) xcd_barrier(xbar); }
        int tid_o = threadIdx.x; asm volatile("" : "+v"(tid_o));
        const int lane = tid_o & 63, wave = __builtin_amdgcn_readfirstlane(tid_o >> 6);
        if (s == 10) {
            if ((PHASE_MASK >> 11) & 1) {
            const int gw = bx * 8 + wave;
            const float* gf = a.in[I_GFINAL];
            for (int m0 = gw; m0 < M; m0 += 3 * ngw) {
                unsigned long long w[3][4]; f32x4 gg[4];
#pragma unroll
                for (int r = 0; r < 3; ++r) { const int m = (m0 + r * ngw) < M ? m0 + r * ngw : m0;
#pragma unroll
                    for (int j = 0; j < 4; ++j) w[r][j] = *(const unsigned long long*)(xbn + (size_t)m * D + j * 256 + lane * 4); }
#pragma unroll
                for (int j = 0; j < 4; ++j) gg[j] = *(const f32x4*)(gf + j * 256 + lane * 4);
#pragma unroll
                for (int r = 0; r < 3; ++r) {
                    const int m = m0 + r * ngw;
                    f32x4 v[4]; float sm = 0.f;
#pragma unroll
                    for (int j = 0; j < 4; ++j) { const unsigned lo = (unsigned)w[r][j], hi = (unsigned)(w[r][j] >> 32);
                        v[j] = (f32x4){bf_lo(lo), bf_hi(lo), bf_lo(hi), bf_hi(hi)}; sm += (v[j][0] * v[j][0] + v[j][1] * v[j][1]) + (v[j][2] * v[j][2] + v[j][3] * v[j][3]); }
                    sm = wave_sum(sm);
                    const float rs = 1.0f / sqrtf(sm * (1.0f / 1024.0f) + EPS);
                    if (m < M) {
#pragma unroll
                        for (int j = 0; j < 4; ++j) *(f32x4*)(xf + (size_t)m * D + j * 256 + lane * 4) = v[j] * rs * gg[j];
                    }
                }
            }
            }
            continue;
        }
        int kind = -1, sync = 1, nj = 0;
        const char* gA = nullptr; const char* gB = nullptr; int lda = 0, ldb = 0, gK = 0, gN = 0, nsub = 1; size_t asub = 0, bsub = 0;
        void* e0 = nullptr; void* e1 = nullptr; const float* e2 = nullptr; float* e3 = nullptr; float scale = 0.f;
        switch (s) {
        case 0: nj = l == 0 ? 2 : 1;
                kind = 0; gA = (const char*)(l == 0 ? xb : xbn); gB = (const char*)(wa + WA_UP1); lda = D; ldb = D; gK = D; gN = 2 * FF; e0 = big; e2 = SSB(l, 0); break;
        case 1: kind = 1; gA = (const char*)big; gB = (const char*)(wa + WA_DN1); lda = FF; ldb = FF; gK = FF; gN = D; e0 = (void*)(l == 0 ? xb : xbn); e1 = xb; e3 = SSB(l, 1); scale = 0.5f; break;
        case 2: nj = l == 0 ? 10 : 8;
                kind = 2; gA = (const char*)xb; gB = (const char*)(wa + WA_IN); lda = D; ldb = D; gK = D; gN = DIN; e0 = big; e2 = SSB(l, 1); break;
        case 3: kind = 3; break;
        case 4: kind = 4; gA = (const char*)mix; gB = (const char*)(wa + WA_ABC); lda = NMIX; ldb = 512; gK = 512; gN = D; nsub = 6; asub = 512 * 2; bsub = (size_t)1024 * 512 * 2; e0 = big; break;
        case 5: kind = 1; gA = (const char*)big; gB = (const char*)(wa + WA_O); lda = DIN; ldb = D; gK = D; gN = D; e0 = xb; e1 = xb; e3 = SSB(l, 2); scale = 1.0f; break;
        case 6: nj = 1;
                kind = 0; gA = (const char*)xb; gB = (const char*)(wa + WA_UP2); lda = D; ldb = D; gK = D; gN = 2 * FF; e0 = big; e2 = SSB(l, 2); break;
        case 7: kind = 1; sync = 0; gA = (const char*)big; gB = (const char*)(wa + WA_DN2); lda = FF; ldb = FF; gK = FF; gN = D; e0 = xb; e1 = xb; e3 = SSB(l, 3); scale = 0.5f; break;
        case 8: kind = 5; gA = (const char*)pb; gB = (const char*)(wa + WA_PROJ); lda = DPLE; ldb = DPLE; gK = DPLE; gN = D; e0 = ppb; break;
        default: kind = 6; gA = (const char*)xb; gB = (const char*)(wa + WA_PG); lda = D; ldb = D; gK = D; gN = D; e0 = xb; e1 = xbn; e2 = SSB(l, 3); e3 = l == 0 ? SSB(1, 0) : nullptr; break;
        }
        if ((PHASE_MASK >> (s + 1)) & 1) {
        if (nj > 0) {
            const int nwg = (M / 256) * (gN / 256), rem = nwg % G;
            if (bx >= rem) {
                const int gw = (bx - rem) * 8 + wave, ngw_l = (G - rem) * 8;
                int total = 0;
                for (int ji = 0; ji < nj; ++ji) { const int id = s == 0 ? (l == 0 ? 1 + ji : 2) : (s == 2 ? (ji < 8 ? 3 + ji : ji - 8) : 11); total += job_items(id); }
                for (int rp = 0; rp < (PROBE == 3 ? 2 : 1); ++rp)
                for (int it = gw; it < total; it += ngw_l) {
                    int r = it, id = 0, jl = l;
                    for (int ji = 0; ji < nj; ++ji) { id = s == 0 ? (l == 0 ? 1 + ji : 2) : (s == 2 ? (ji < 8 ? 3 + ji : ji - 8) : 11); jl = (s == 2 && ji >= 8) ? 1 : l; const int c = job_items(id); if (r < c) break; r -= c; }
                    if (id == 5) {
                        const float* cw = a.in[I_CW] + (size_t)jl * 4 * 128 * 128; const float* cs = a.in[I_CSCALE] + jl * 512; const float* co = a.in[I_COUT] + (size_t)jl * 512 * D;
                        bf16_t* wdst = (bf16_t*)(wa + WA_ABC);
                        const int i = r * 64 + lane;
                        const int k0 = (i >> 10) * 8, n = i & 1023, gq = k0 >> 7;
                        const float* cwr = cw + (size_t)k0 * 128; const float* csr = cs + gq * 128; const float* cor = co + (size_t)(gq * 128) * D + n;
                        float sm[8];
#pragma unroll
                        for (int j = 0; j < 8; ++j) sm[j] = 0.f;
#pragma unroll 8
                        for (int d = 0; d < 128; ++d) { const float v = csr[d] * cor[(size_t)d * D];
#pragma unroll
                            for (int j = 0; j < 8; ++j) sm[j] += cwr[j * 128 + d] * v; }
                        u32x4 o; o.x = cvt_pk_bf16(sm[0], sm[1]); o.y = cvt_pk_bf16(sm[2], sm[3]); o.z = cvt_pk_bf16(sm[4], sm[5]); o.w = cvt_pk_bf16(sm[6], sm[7]);
                        *(u32x4*)(wdst + (size_t)(2048 + n) * 512 + k0) = o;
                    } else if (id == 11) {
                        const float* ppr = a.in[I_PP] + (size_t)jl * MP * DPLE; const float* psm = a.in[I_PS] + (size_t)jl * MS * DPLE;
#pragma unroll
                        for (int q = 0; q < 4; ++q) {
                            const size_t e = ((size_t)r * 256 + q * 64 + lane) * 8; const float* src = e < (size_t)MP * DPLE ? ppr + e : psm + (e - (size_t)MP * DPLE);
                            const F8 v = ld_f8(src); *(u32x4*)(pb + e) = pack8(v.a, v.b);
                        }
                    } else {
                        const float* jW; const float* jG = nullptr; unsigned char* jD; int jK, jN, jL, jR = 0, jM = 0;
                        switch (id) {
                        case 0: jW = a.in[I_WUP1] + (size_t)jl * D * 2 * FF; jG = a.in[I_GFFN1] + jl * D; jD = wa + WA_UP1; jK = D; jN = 2 * FF; jL = D; jM = 1; break;
                        case 1: jW = a.in[I_WDN1] + (size_t)jl * FF * D; jD = wa + WA_DN1; jK = FF; jN = D; jL = FF; break;
                        case 2: jW = a.in[I_WIN] + (size_t)jl * D * DIN; jG = a.in[I_GMIX] + jl * D; jD = wa + WA_IN; jK = D; jN = DIN; jL = D; break;
                        case 3: jW = a.in[I_AOUT] + (size_t)jl * 512 * D; jD = wa + WA_ABC; jK = 512; jN = D; jL = 512; break;
                        case 4: jW = a.in[I_BOUT] + (size_t)jl * 512 * D; jD = wa + WA_ABC; jK = 512; jN = D; jL = 512; jR = 1024; break;
                        case 6: jW = a.in[I_WO] + (size_t)jl * D * D; jD = wa + WA_O; jK = D; jN = D; jL = D; break;
                        case 7: jW = a.in[I_WUP2] + (size_t)jl * D * 2 * FF; jG = a.in[I_GFFN2] + jl * D; jD = wa + WA_UP2; jK = D; jN = 2 * FF; jL = D; jM = 1; break;
                        case 8: jW = a.in[I_WDN2] + (size_t)jl * FF * D; jD = wa + WA_DN2; jK = FF; jN = D; jL = FF; break;
                        case 9: jW = a.in[I_WPP] + (size_t)jl * DPLE * D; jD = wa + WA_PROJ; jK = DPLE; jN = D; jL = DPLE; break;
                        default: jW = a.in[I_WPG] + (size_t)jl * D * D; jG = a.in[I_GPLE] + jl * D; jD = wa + WA_PG; jK = D; jN = D; jL = D; break;
                        }
                        convert_item(jM, jW, jN, jG, (bf16_t*)jD, jL, jR, r, lane);
                    }
                }
            }
        }
        for (int rb = 0; rb < (((PROBE == 1 && s == 0) || (PROBE == 2 && s == 3) || (PROBE == 5 && (s == 1 || s == 7)) || (PROBE == 6 && s == 4) || (PROBE == 7 && s == 5) || (PROBE == 11 && s == 7)) ? 2 : 1); ++rb) {
        if (PROBE >= 5 && rb == 1) scale = 0.f;
        if (kind == 3) {
            for (int q = 0; q < (PROBE == 8 ? 2 : 1); ++q) mixer_a(a, l, lds, big, mix, wsb, G);
            for (int q = 0; q < (PROBE == 9 ? 2 : 1); ++q) mixer_bc(a, l, big, mix, G);
        } else {
            const bool narrow = (kind == 1 || kind >= 4);
            pg8::Gemm g{gA, gB, lda, ldb, gK, asub, bsub}; pg8::StaticOrder S; S.init(narrow ? MP : M, gN, G, bx, nsub);
            switch (kind) {
            case 0: { EpiSwiglu E{(bf16_t*)e0, e2, lds}; pg8::gemm_phase(lds, g, S, E); } break;
            case 1: { EpiResid E{(const bf16_t*)e0, (bf16_t*)e1, e3, scale}; pg8::gemm_phase(lds, g, S, E); } break;
            case 2: { EpiZin E{(bf16_t*)e0, e2, lds}; pg8::gemm_phase(lds, g, S, E); } break;
            case 4: { EpiMergeH E{(unsigned char*)e0}; pg8::gemm_phase<EpiMergeH, true>(lds, g, S, E); } break;
            case 5: { EpiPP E{(bf16_t*)e0}; pg8::gemm_phase(lds, g, S, E); } break;
            default: { EpiPle E{(const bf16_t*)e0, (bf16_t*)e1, ppb, e2, e3, lds}; pg8::gemm_phase(lds, g, S, E); } break;
            }
            if (narrow) for (int q = 0; q < (((PROBE == 10 && kind != 6) || (PROBE == 12 && s == 7)) ? 2 : 1); ++q) skinny_phase(kind, lds, gA, gB, lda, ldb, gK, asub, bsub, e0, e1, e2, e3, q ? 0.f : scale, ppb, big, G);
        }
        }
        }
    }

}

extern "C" void kernel_launch(void* const* d_in, const int* in_sizes, int n_in, void* d_out, int out_size, void* d_ws, size_t ws_size, hipStream_t stream) {
    static int grid = 0;
    if (grid == 0) {
        if (n_in != 29 || ws_size < WS_END) { fprintf(stderr, "kernel_launch: need 29 inputs and >= %zu bytes of workspace; got %d, %zu\n", (size_t)WS_END, n_in, ws_size); grid = -1; return; }
        int dev = 0, cus = 0, per_cu = 0;
        if (hipGetDevice(&dev) != hipSuccess || hipDeviceGetAttribute(&cus, hipDeviceAttributeMultiprocessorCount, dev) != hipSuccess) { grid = -1; return; }
        if (hipFuncSetAttribute((const void*)fwd_kernel, hipFuncAttributeMaxDynamicSharedMemorySize, LDS_BYTES) != hipSuccess) { fprintf(stderr, "kernel_launch: hipFuncSetAttribute failed\n"); grid = -1; return; }
        if (hipOccupancyMaxActiveBlocksPerMultiprocessor(&per_cu, (const void*)fwd_kernel, NT, LDS_BYTES) != hipSuccess || per_cu < 1) { fprintf(stderr, "kernel_launch: occupancy query says %d\n", per_cu); grid = -1; return; }
        grid = cus * per_cu;
    }
    if (grid < 0) return;
    if (hipMemsetAsync((char*)d_ws + WS_BAR, 0, XCD_BAR_WORDS * 4, stream) != hipSuccess) { fprintf(stderr, "kernel_launch: memset failed\n"); return; }
    KArgs a{};
    for (int i = 0; i < 29; ++i) a.in[i] = (const float*)d_in[i];
    a.out = (float*)d_out; a.ws = (unsigned char*)d_ws;
    void* args[] = {&a};
    hipError_t e = hipLaunchCooperativeKernel((const void*)fwd_kernel, dim3(grid), dim3(NT), args, LDS_BYTES, stream);
    if (e != hipSuccess) fprintf(stderr, "cooperative launch failed: %s (grid %d)\n", hipGetErrorString(e), grid);
}
```

```cpp
#include <hip/hip_runtime.h>
#include <hip/hip_cooperative_groups.h>
#include <cstdio>
#include <cstdint>
namespace cg = cooperative_groups;

#define LAS __attribute__((address_space(3)))
typedef unsigned short bf16_t;
typedef short bf16x8 __attribute__((ext_vector_type(8)));
typedef float f32x4 __attribute__((ext_vector_type(4)));
typedef unsigned u32x4 __attribute__((ext_vector_type(4)));

constexpr int MP = 16384, MS = 512, M = MP + MS;
constexpr int D = 1024, FF = 2816, DIN = 6144, DPLE = 256;
constexpr int NMIX = 1536;
constexpr float EPS = 1e-6f;
constexpr int NT = 512;

constexpr size_t O_CONVP = 17301504, O_CONVS = 17317888, O_POOLP = 17580032, O_POOLS = 17702912, O_VAS = 19668992;

constexpr size_t MiB = 1u << 20;
constexpr size_t WS_SS = 0;
constexpr size_t SS_BUF = (size_t)M * 16 * 4;
constexpr size_t WS_WSB = 9 * MiB;
constexpr size_t WS_BAR = 9 * MiB + 512 * 1024;
constexpr size_t WS_W0 = 10 * MiB, WS_W1 = 22 * MiB;
constexpr size_t WS_XB = 34 * MiB;
constexpr size_t WS_MIX = 67 * MiB;
constexpr size_t WS_BIG = 117 * MiB;
constexpr size_t WS_END = WS_BIG + (size_t)M * DIN * 2;
constexpr size_t XBN_OFF = 16 * MiB, PP_OFF = 100 * MiB;
constexpr size_t WA_UP1 = 0, WA_DN1 = 12 * MiB, WA_IN = 18 * MiB, WA_ABC = 30 * MiB, WA_O = 33 * MiB, WA_UP2 = 35 * MiB, WA_DN2 = 47 * MiB, WA_PROJ = 53 * MiB, WA_PG = 54 * MiB;

#ifndef PROBE
#define PROBE 0
#endif
#ifndef PHASE_MASK
#define PHASE_MASK 0xFFFF
#endif
constexpr int RING_BYTES = 131072;
constexpr int LDS_BYTES = 147456;

__device__ __forceinline__ unsigned cvt_pk_bf16(float lo, float hi) { unsigned r; asm volatile("v_cvt_pk_bf16_f32 %0, %1, %2" : "=v"(r) : "v"(lo), "v"(hi)); return r; }
__device__ __forceinline__ float bf_lo(unsigned w) { return __builtin_bit_cast(float, w << 16); }
__device__ __forceinline__ float bf_hi(unsigned w) { return __builtin_bit_cast(float, w & 0xffff0000u); }
struct F8 { f32x4 a, b; };
__device__ __forceinline__ F8 unpack8(u32x4 w) { F8 r; r.a = (f32x4){bf_lo(w.x), bf_hi(w.x), bf_lo(w.y), bf_hi(w.y)}; r.b = (f32x4){bf_lo(w.z), bf_hi(w.z), bf_lo(w.w), bf_hi(w.w)}; return r; }
__device__ __forceinline__ u32x4 pack8(f32x4 a, f32x4 b) { u32x4 w; w.x = cvt_pk_bf16(a[0], a[1]); w.y = cvt_pk_bf16(a[2], a[3]); w.z = cvt_pk_bf16(b[0], b[1]); w.w = cvt_pk_bf16(b[2], b[3]); return w; }
__device__ __forceinline__ F8 ld_bf8(const bf16_t* p) { return unpack8(*(const u32x4*)p); }
__device__ __forceinline__ F8 ld_f8(const float* p) { F8 r; r.a = *(const f32x4*)p; r.b = *(const f32x4*)(p + 4); return r; }
__device__ __forceinline__ float sigmoidf_(float x) { return __builtin_amdgcn_rcpf(1.0f + __builtin_amdgcn_exp2f(-1.4426950408889634f * x)); }
__device__ __forceinline__ float siluf_(float x) { return x * sigmoidf_(x); }
__device__ __forceinline__ float gelu_tanh_(float x) { const float y = 0.7978845608028654f * (x + 0.044715f * x * x * x); return x * sigmoidf_(2.0f * y); }
__device__ __forceinline__ float wave_sum(float v) {
#pragma unroll
    for (int o = 1; o < 64; o <<= 1) v += __shfl_xor(v, o);
    return v;
}
__device__ __forceinline__ float row_rstd(const float* ss, int row) {
    const f32x4* p = (const f32x4*)(ss + (size_t)row * 16);
    const f32x4 a = p[0], b = p[1], c = p[2], d = p[3];
    const f32x4 s = (a + b) + (c + d);
    const float t = (s[0] + s[1]) + (s[2] + s[3]);
    return __builtin_amdgcn_rsqf(t * (1.0f / 1024.0f) + EPS);
}

namespace pg8 {
constexpr int BM = 256, BK = 64, HALF = 128, HTB = HALF * BK * 2, NXCD = 8, WGM = 8;
__host__ __device__ __forceinline__ int lds_byte(int r, int c) { const int st = (r >> 4) * 2 + (c >> 5), rr = r & 15, cc = c & 31, ob = rr * 64 + cc * 2; return st * 1024 + (ob ^ (((ob >> 9) & 1) << 5)); }
__host__ __device__ __forceinline__ void stage_rc(int b, int& R, int& C) { const int st = b / 1024, sb = b % 1024, swz = sb ^ (((sb >> 9) & 1) << 5); R = (st >> 1) * 16 + swz / 64; C = (st & 1) * 32 + (swz % 64) / 2; }
__host__ __device__ __forceinline__ int perm32(int rho) { const int n = rho >> 4, i = rho & 15; return 8 * (i >> 2) + 4 * n + (i & 3); }

struct Unit { int pm, pn, sub; };
struct Gemm { const char* A; const char* Bt; int lda, ldb, K; size_t a_sub, b_sub; };

struct StaticOrder {
    int nM, nN, nwg, G, c, nsub;
    __device__ void init(int M_, int N_, int G_, int c_, int nsub_) { nM = M_ / BM; nN = N_ / BM; nwg = nM * nN; G = G_; c = c_; nsub = nsub_; }
    __device__ bool next(int i, Unit& u) const {
        const int ib = i / nsub; u.sub = i - ib * nsub;
        const long L = (long)ib * G + c; if (L >= nwg) return false;
        int wgid = (int)L; { const int q = nwg / NXCD, r = nwg % NXCD, xcd = wgid % NXCD, off = wgid / NXCD; wgid = (xcd < r ? xcd * (q + 1) : r * (q + 1) + (xcd - r) * q) + off; }
        const int nig = WGM * nN, gid = wgid / nig, fm = gid * WGM, gsz = (nM - fm) < WGM ? (nM - fm) : WGM;
        u.pm = fm + ((wgid % nig) % gsz); u.pn = (wgid % nig) / gsz; return true;
    }
};

template <class Epi, bool HALFN = false>
__device__ __forceinline__ void gemm_phase(LAS unsigned char* lds, const Gemm g, const StaticOrder& S, const Epi& E) {
    int tid = threadIdx.x; asm volatile("" : "+v"(tid));
    const int wid = __builtin_amdgcn_readfirstlane(tid >> 6), lane = tid & 63, wr = wid >> 2, wc = wid & 3, fr = lane & 15, fq = lane >> 4;
    const int K = g.K, nt = K / BK;
    unsigned voffA[2], voffB[2];
#pragma unroll
    for (int i = 0; i < 2; ++i) { int R, C; stage_rc(tid * 16 + i * 8192, R, C); const int Rb = (R & ~31) + perm32(R & 31);
        voffA[i] = (unsigned)(R * g.lda + C) * 2u; voffB[i] = (unsigned)(Rb * g.ldb + C) * 2u; }
    const size_t kstep = (size_t)(BK * 2);
    const size_t hstepA = (size_t)HALF * g.lda * 2, hstepB = (size_t)HALF * g.ldb * 2;
    const size_t tstepA = 2 * hstepA, tstepB = 2 * hstepB;
    const unsigned ldsw = (unsigned)wid * 1024u;
    const int aoff = lds_byte(wr * 64 + fr, fq * 8), boff = lds_byte(wc * 32 + fr, fq * 8);
#define PG8_SA(b, h) (((b) * 2 + (h)) * HTB)
#define PG8_SB(b, h) ((4 + (b) * 2 + (h)) * HTB)
#define PG8_STAGE(bufoff, gbase, voff) do { _Pragma("unroll") for (int _i = 0; _i < 2; ++_i) \
        __builtin_amdgcn_global_load_lds((const unsigned*)((const char*)(gbase) + (voff)[_i]), (LAS unsigned*)(lds + (bufoff) + ldsw + _i * 8192), 16, 0, 0); } while (0)
#define PG8_LDA(dst, b, h) do { _Pragma("unroll") for (int m = 0; m < 4; ++m) _Pragma("unroll") for (int k = 0; k < 2; ++k) dst[m][k] = *(const LAS bf16x8*)(lds + PG8_SA(b, h) + aoff + m * 2048 + k * 1024); } while (0)
#define PG8_LDB(dst, b, h) do { _Pragma("unroll") for (int n = 0; n < 2; ++n) _Pragma("unroll") for (int k = 0; k < 2; ++k) dst[n][k] = *(const LAS bf16x8*)(lds + PG8_SB(b, h) + boff + n * 2048 + k * 1024); } while (0)
#define PG8_MMA(ai, bj, At, Bt) do { __builtin_amdgcn_s_setprio(1); _Pragma("unroll") for (int m = 0; m < 4; ++m) _Pragma("unroll") for (int n = 0; n < 2; ++n) _Pragma("unroll") for (int k = 0; k < 2; ++k) \
        acc[ai][bj][m][n] = __builtin_amdgcn_mfma_f32_16x16x32_bf16(Bt[n][k], At[m][k], acc[ai][bj][m][n], 0, 0, 0); __builtin_amdgcn_s_setprio(0); } while (0)
#define PG8_WAIT_V(n) asm volatile("s_waitcnt vmcnt(" #n ")" ::: "memory")
#define PG8_WAIT_L(n) asm volatile("s_waitcnt lgkmcnt(" #n ")" ::: "memory")
#define PG8_BAR __builtin_amdgcn_s_barrier()
#define PG8_SCHED __builtin_amdgcn_sched_barrier(0)
    Unit cur, nxt; int ui = 0;
    if (!S.next(0, cur)) return;
    f32x4 acc[2][2][4][2];
#pragma unroll
    for (int a = 0; a < 2; ++a)
#pragma unroll
        for (int b = 0; b < 2; ++b)
#pragma unroll
            for (int m = 0; m < 4; ++m)
#pragma unroll
                for (int n = 0; n < 2; ++n) acc[a][b][m][n] = (f32x4){0.f, 0.f, 0.f, 0.f};
    bf16x8 At[4][2], B0[2][2], B1[2][2];
#define PG8_UA(u_) (g.A + (size_t)(u_).pm * tstepA + (size_t)(HALFN ? (u_).sub % 3 : (u_).sub) * g.a_sub)
#define PG8_UB(u_) (g.Bt + (size_t)(u_).pn * tstepB + (HALFN ? (size_t)((u_).sub / 3) * hstepB : (size_t)0) + (size_t)(HALFN ? (u_).sub % 3 : (u_).sub) * g.b_sub)
    const char* cA = PG8_UA(cur); const char* cB = PG8_UB(cur);
    f32x4 msum[2][4][2];
    if constexpr (HALFN) {
#pragma unroll
        for (int a = 0; a < 2; ++a)
#pragma unroll
            for (int m = 0; m < 4; ++m)
#pragma unroll
                for (int n = 0; n < 2; ++n) msum[a][m][n] = (f32x4){0.f, 0.f, 0.f, 0.f};
    }
    PG8_STAGE(PG8_SB(0, 0), cB, voffB); PG8_STAGE(PG8_SB(0, 1), cB + hstepB, voffB); PG8_STAGE(PG8_SA(0, 0), cA, voffA); PG8_STAGE(PG8_SA(0, 1), cA + hstepA, voffA);
    if (wr == 1) PG8_BAR;
    PG8_WAIT_V(2); PG8_BAR;
    PG8_STAGE(PG8_SB(1, 0), cB + kstep, voffB); PG8_STAGE(PG8_SA(1, 0), cA + kstep, voffA); PG8_STAGE(PG8_SB(1, 1), cB + hstepB + kstep, voffB);
    PG8_WAIT_V(6); PG8_BAR;
    for (;;) {
        const bool has_next = S.next(ui + 1, nxt);
        const char* nA = has_next ? PG8_UA(nxt) : cA;
        const char* nB = has_next ? PG8_UB(nxt) : cB;
        for (int t = 0; t < nt; t += 2) {
            const bool last = (t == nt - 2);
            const char* a1 = cA + (size_t)(t + 1) * kstep;
            const char* a2 = last ? nA : cA + (size_t)(t + 2) * kstep; const char* b2 = last ? nB : cB + (size_t)(t + 2) * kstep;
            const char* a3 = a2 + kstep; const char* b3 = b2 + kstep;
            PG8_LDB(B0, 0, 0); if constexpr (!HALFN) PG8_LDB(B1, 0, 1); PG8_SCHED; PG8_LDA(At, 0, 0); PG8_STAGE(PG8_SA(1, 1), a1 + hstepA, voffA);
            PG8_WAIT_V(8); PG8_WAIT_L(0); PG8_BAR; PG8_MMA(0, 0, At, B0); if constexpr (!HALFN) PG8_MMA(0, 1, At, B1); PG8_BAR; PG8_SCHED;
            PG8_LDA(At, 0, 1); PG8_STAGE(PG8_SB(0, 0), b2, voffB); PG8_STAGE(PG8_SB(0, 1), b2 + hstepB, voffB); PG8_STAGE(PG8_SA(0, 0), a2, voffA);
            PG8_WAIT_V(8); PG8_WAIT_L(0); PG8_BAR; PG8_MMA(1, 0, At, B0); if constexpr (!HALFN) PG8_MMA(1, 1, At, B1); PG8_BAR; PG8_SCHED;
            PG8_LDB(B0, 1, 0); if constexpr (!HALFN) PG8_LDB(B1, 1, 1); PG8_SCHED; PG8_LDA(At, 1, 0); PG8_STAGE(PG8_SA(0, 1), a2 + hstepA, voffA);
            PG8_WAIT_V(8); PG8_WAIT_L(0); PG8_BAR; PG8_MMA(0, 0, At, B0); if constexpr (!HALFN) PG8_MMA(0, 1, At, B1); PG8_BAR; PG8_SCHED;
            PG8_LDA(At, 1, 1); PG8_STAGE(PG8_SB(1, 0), b3, voffB); PG8_STAGE(PG8_SB(1, 1), b3 + hstepB, voffB); PG8_STAGE(PG8_SA(1, 0), a3, voffA);
            PG8_WAIT_V(8); PG8_WAIT_L(0); PG8_BAR; PG8_MMA(1, 0, At, B0); if constexpr (!HALFN) PG8_MMA(1, 1, At, B1); PG8_BAR; PG8_SCHED;
        }
        if (wr == 0) PG8_BAR;
        if constexpr (HALFN) E(acc, msum, cur, wr, wc, fr, fq); else E(acc, cur, wr, wc, fr, fq);
        if (!has_next) break;
#pragma unroll
        for (int a = 0; a < 2; ++a)
#pragma unroll
            for (int b = 0; b < 2; ++b)
#pragma unroll
                for (int m = 0; m < 4; ++m)
#pragma unroll
                    for (int n = 0; n < 2; ++n) acc[a][b][m][n] = (f32x4){0.f, 0.f, 0.f, 0.f};
        cur = nxt; cA = nA; cB = nB; ++ui;
        if (wr == 1) PG8_BAR;
    }
    PG8_WAIT_V(0);
    PG8_BAR;
#undef PG8_UA
#undef PG8_UB
#undef PG8_SA
#undef PG8_SB
#undef PG8_STAGE
#undef PG8_LDA
#undef PG8_LDB
#undef PG8_MMA
#undef PG8_WAIT_V
#undef PG8_WAIT_L
#undef PG8_BAR
#undef PG8_SCHED
}
}
using pg8::Unit;

#define EPI_ARGS const f32x4 (&acc)[2][2][4][2], const Unit& u, int wr, int wc, int fr, int fq

constexpr int TBL_OFF = RING_BYTES + 64;
__device__ __forceinline__ const LAS float* fill_rstd_table(LAS unsigned char* lds, const float* ss, int pm, int wr, int wc, int fr, int fq) {
    LAS float* tbl = (LAS float*)(lds + TBL_OFF);
    const int t = (wr * 4 + wc) * 64 + fq * 16 + fr;
    if (t < 256) tbl[t] = row_rstd(ss, pm * 256 + t);
    asm volatile("s_waitcnt lgkmcnt(0)" ::: "memory"); __builtin_amdgcn_s_barrier(); asm volatile("" ::: "memory");
    return tbl;
}
struct EpiSwiglu {
    bf16_t* act; const float* ss; LAS unsigned char* lds;
    __device__ __forceinline__ void operator()(EPI_ARGS) const {
        const LAS float* tbl = fill_rstd_table(lds, ss, u.pm, wr, wc, fr, fq);
        const int row0 = u.pm * 256 + wr * 64 + fr, col0 = u.pn * 128 + wc * 32 + 8 * fq;
#pragma unroll
        for (int ai = 0; ai < 2; ++ai)
#pragma unroll
            for (int m = 0; m < 4; ++m) {
                const int row = row0 + ai * 128 + m * 16; const float rs = tbl[ai * 128 + wr * 64 + m * 16 + fr];
                f32x4 o[2];
#pragma unroll
                for (int n = 0; n < 2; ++n) { const f32x4 gt = acc[ai][0][m][n] * rs, up = acc[ai][1][m][n] * rs;
#pragma unroll
                    for (int j = 0; j < 4; ++j) o[n][j] = siluf_(gt[j]) * up[j]; }
                *(u32x4*)(act + (size_t)row * FF + col0) = pack8(o[0], o[1]);
            }
    }
};
struct EpiResid {
    const bf16_t* xin; bf16_t* xout; float* ss_out; float scale;
    __device__ __forceinline__ void operator()(EPI_ARGS) const {
        const int row0 = u.pm * 256 + wr * 64 + fr, col0 = u.pn * 256 + wc * 32 + 8 * fq;
        u32x4 xr[8][2];
#pragma unroll
        for (int g = 0; g < 8; ++g)
#pragma unroll
            for (int bj = 0; bj < 2; ++bj) xr[g][bj] = *(const u32x4*)(xin + (size_t)(row0 + (g >> 2) * 128 + (g & 3) * 16) * D + col0 + bj * 128);
        asm volatile("" ::: "memory");
#pragma unroll
        for (int ai = 0; ai < 2; ++ai)
#pragma unroll
            for (int m = 0; m < 4; ++m) {
                const int row = row0 + ai * 128 + m * 16; const size_t off = (size_t)row * D + col0; float sq = 0.f;
#pragma unroll
                for (int bj = 0; bj < 2; ++bj) {
                    const F8 xv = unpack8(xr[ai * 4 + m][bj]);
                    const f32x4 x0 = xv.a + acc[ai][bj][m][0] * scale, x1 = xv.b + acc[ai][bj][m][1] * scale;
                    *(u32x4*)(xout + off + bj * 128) = pack8(x0, x1);
                    sq += (x0[0] * x0[0] + x0[1] * x0[1]) + (x0[2] * x0[2] + x0[3] * x0[3]) + (x1[0] * x1[0] + x1[1] * x1[1]) + (x1[2] * x1[2] + x1[3] * x1[3]);
                }
                sq += __shfl_xor(sq, 16); sq += __shfl_xor(sq, 32);
                if (fq == 0) ss_out[(size_t)row * 16 + u.pn * 4 + wc] = sq;
            }
    }
};
struct EpiZin {
    bf16_t* z; const float* ss; LAS unsigned char* lds;
    __device__ __forceinline__ void operator()(EPI_ARGS) const {
        const LAS float* tbl = fill_rstd_table(lds, ss, u.pm, wr, wc, fr, fq);
        const int row0 = u.pm * 256 + wr * 64 + fr, col0 = u.pn * 256 + wc * 32 + 8 * fq;
        const int mode = u.pn < 4 ? 1 : (u.pn < 12 ? 0 : 2);
#pragma unroll
        for (int ai = 0; ai < 2; ++ai)
#pragma unroll
            for (int m = 0; m < 4; ++m) {
                const int row = row0 + ai * 128 + m * 16; const float rs = tbl[ai * 128 + wr * 64 + m * 16 + fr];
#pragma unroll
                for (int bj = 0; bj < 2; ++bj) {
                    f32x4 v0 = acc[ai][bj][m][0] * rs, v1 = acc[ai][bj][m][1] * rs;
                    if (mode == 1) {
#pragma unroll
                        for (int j = 0; j < 4; ++j) { v0[j] = gelu_tanh_(v0[j]); v1[j] = gelu_tanh_(v1[j]); }
                    } else if (mode == 2) {
#pragma unroll
                        for (int j = 0; j < 4; ++j) { v0[j] = sigmoidf_(v0[j]); v1[j] = sigmoidf_(v1[j]); }
                    }
                    *(u32x4*)(z + (size_t)row * DIN + col0 + bj * 128) = pack8(v0, v1);
                }
            }
    }
};
struct EpiMerge {
    unsigned char* zb;
    __device__ __forceinline__ void operator()(EPI_ARGS) const {
        const int row0 = u.pm * 256 + wr * 64 + fr, col0 = u.pn * 256 + wc * 32 + 8 * fq; const int sub = u.sub;
#pragma unroll
        for (int ai = 0; ai < 2; ++ai) {
            u32x4 gt[4][2], pr[4][2];
#pragma unroll
            for (int m = 0; m < 4; ++m) {
                unsigned char* rp = zb + (size_t)(row0 + ai * 128 + m * 16) * (DIN * 2);
#pragma unroll
                for (int bj = 0; bj < 2; ++bj) { const int col = col0 + bj * 128;
                    gt[m][bj] = *(const u32x4*)(rp + (size_t)(3072 + sub * 1024 + col) * 2);
                    if (sub > 0) pr[m][bj] = *(const u32x4*)(rp + (size_t)col * 2); }
            }
            asm volatile("" ::: "memory");
#pragma unroll
            for (int m = 0; m < 4; ++m) {
                unsigned char* rp = zb + (size_t)(row0 + ai * 128 + m * 16) * (DIN * 2);
#pragma unroll
                for (int bj = 0; bj < 2; ++bj) { const int col = col0 + bj * 128;
                    const F8 gv = unpack8(gt[m][bj]);
                    f32x4 v0 = acc[ai][bj][m][0] * gv.a, v1 = acc[ai][bj][m][1] * gv.b;
                    if (sub > 0) { const F8 pv = unpack8(pr[m][bj]); v0 += pv.a; v1 += pv.b; }
                    *(u32x4*)(rp + (size_t)col * 2) = pack8(v0, v1); }
            }
            asm volatile("" ::: "memory");
        }
    }
};
struct EpiMergeH {
    unsigned char* zb;
    __device__ __forceinline__ void operator()(const f32x4 (&acc)[2][2][4][2], f32x4 (&msum)[2][4][2], const Unit& u, int wr, int wc, int fr, int fq) const {
        const int b = u.sub % 3, h = u.sub / 3;
        const int row0 = u.pm * 256 + wr * 64 + fr, col = u.pn * 256 + h * 128 + wc * 32 + 8 * fq;
        u32x4 gt[2][4];
#pragma unroll
        for (int ai = 0; ai < 2; ++ai)
#pragma unroll
            for (int m = 0; m < 4; ++m) gt[ai][m] = *(const u32x4*)(zb + (size_t)(row0 + ai * 128 + m * 16) * (DIN * 2) + (size_t)(3072 + b * 1024 + col) * 2);
#pragma unroll
        for (int ai = 0; ai < 2; ++ai)
#pragma unroll
            for (int m = 0; m < 4; ++m) {
                const F8 gv = unpack8(gt[ai][m]);
                f32x4 v0 = acc[ai][0][m][0] * gv.a, v1 = acc[ai][0][m][1] * gv.b;
                if (b > 0) { v0 += msum[ai][m][0]; v1 += msum[ai][m][1]; }
                if (b < 2) { msum[ai][m][0] = v0; msum[ai][m][1] = v1; }
                else *(u32x4*)(zb + (size_t)(row0 + ai * 128 + m * 16) * (DIN * 2) + (size_t)col * 2) = pack8(v0, v1);
            }
    }
};
struct EpiPP {
    bf16_t* o;
    __device__ __forceinline__ void operator()(EPI_ARGS) const {
        const int row0 = u.pm * 256 + wr * 64 + fr, col0 = u.pn * 256 + wc * 32 + 8 * fq;
#pragma unroll
        for (int ai = 0; ai < 2; ++ai)
#pragma unroll
            for (int m = 0; m < 4; ++m) {
                const int row = row0 + ai * 128 + m * 16;
#pragma unroll
                for (int bj = 0; bj < 2; ++bj) *(u32x4*)(o + (size_t)row * D + col0 + bj * 128) = pack8(acc[ai][bj][m][0], acc[ai][bj][m][1]);
            }
    }
};
struct EpiPle {
    const bf16_t* xin; bf16_t* xout; const bf16_t* pp; const float* ss; float* ss_out; LAS unsigned char* lds;
    __device__ __forceinline__ void operator()(EPI_ARGS) const {
        const LAS float* tbl = fill_rstd_table(lds, ss, u.pm, wr, wc, fr, fq);
        const int row0 = u.pm * 256 + wr * 64 + fr, col0 = u.pn * 256 + wc * 32 + 8 * fq;
#pragma unroll
        for (int ai = 0; ai < 2; ++ai) {
            u32x4 pw[4][2], xw[4][2];
#pragma unroll
            for (int m = 0; m < 4; ++m) {
                const size_t off = (size_t)(row0 + ai * 128 + m * 16) * D + col0;
#pragma unroll
                for (int bj = 0; bj < 2; ++bj) { pw[m][bj] = *(const u32x4*)(pp + off + bj * 128); xw[m][bj] = *(const u32x4*)(xin + off + bj * 128); }
            }
            asm volatile("" ::: "memory");
#pragma unroll
            for (int m = 0; m < 4; ++m) {
                const int row = row0 + ai * 128 + m * 16; const size_t off = (size_t)row * D + col0; const float rs = tbl[ai * 128 + wr * 64 + m * 16 + fr]; float sq = 0.f;
#pragma unroll
                for (int bj = 0; bj < 2; ++bj) {
                    const F8 p = unpack8(pw[m][bj]); const F8 xr = unpack8(xw[m][bj]);
                    f32x4 x0 = xr.a, x1 = xr.b;
                    const f32x4 a0 = acc[ai][bj][m][0] * rs, a1 = acc[ai][bj][m][1] * rs;
#pragma unroll
                    for (int j = 0; j < 4; ++j) { x0[j] += sigmoidf_(a0[j]) * p.a[j]; x1[j] += sigmoidf_(a1[j]) * p.b[j]; }
                    *(u32x4*)(xout + off + bj * 128) = pack8(x0, x1);
                    sq += (x0[0] * x0[0] + x0[1] * x0[1]) + (x0[2] * x0[2] + x0[3] * x0[3]) + (x1[0] * x1[0] + x1[1] * x1[1]) + (x1[2] * x1[2] + x1[3] * x1[3]);
                }
                sq += __shfl_xor(sq, 16); sq += __shfl_xor(sq, 32);
                if (ss_out && fq == 0) ss_out[(size_t)row * 16 + u.pn * 4 + wc] = sq;
            }
            asm volatile("" ::: "memory");
        }
    }
};

__device__ __forceinline__ void convert_item(int MAP, const float* __restrict__ W, int N, const float* __restrict__ gsc, bf16_t* WT, int ldt, int row_off, int it, int lane) {
    const int nblk = N / 64;
    const int kb = it / nblk, nb = it - kb * nblk, n0 = 64 * nb, k0 = 64 * kb;
    int orow0;
    if (MAP == 0) orow0 = row_off + n0;
    else { const int h = n0 < FF ? n0 : n0 - FF; orow0 = (h >> 7) * 256 + (h & 127) + (n0 < FF ? 0 : 128); }
    const float* src = W + (size_t)k0 * N + n0 + lane;
    float v[64];
#pragma unroll
    for (int i = 0; i < 64; ++i) v[i] = src[(size_t)i * N];
    if (gsc) {
#pragma unroll
        for (int i = 0; i < 64; ++i) v[i] *= gsc[k0 + i];
    }
    bf16_t* dst = WT + (size_t)(orow0 + lane) * ldt + k0;
#pragma unroll
    for (int c = 0; c < 8; ++c) { u32x4 o; o.x = cvt_pk_bf16(v[8 * c], v[8 * c + 1]); o.y = cvt_pk_bf16(v[8 * c + 2], v[8 * c + 3]); o.z = cvt_pk_bf16(v[8 * c + 4], v[8 * c + 5]); o.w = cvt_pk_bf16(v[8 * c + 6], v[8 * c + 7]);
        *(u32x4*)(dst + 8 * c) = o; }
}
__device__ __forceinline__ void convert_job(int MAP, const float* __restrict__ W, int K, int N, const float* __restrict__ gsc, bf16_t* WT, int ldt, int row_off, int gw, int ngw, LAS float* scr, int lane) {
    const int items = (K / 64) * (N / 64);
    for (int it = gw; it < items; it += ngw) convert_item(MAP, W, N, gsc, WT, ldt, row_off, it, lane);
}
__device__ __forceinline__ int job_items(int id) {
    switch (id) {
    case 0: case 7: return (D / 64) * (2 * FF / 64);
    case 1: case 8: return (FF / 64) * (D / 64);
    case 2: return (D / 64) * (DIN / 64);
    case 3: case 4: return (512 / 64) * (D / 64);
    case 5: return 1024;
    case 6: case 10: return (D / 64) * (D / 64);
    case 9: return (DPLE / 64) * (D / 64);
    default: return M * DPLE / 8 / 256;
    }
}

#define XB_TMO      128
#define XB_XCNT(j)  (256  + 64 * (j))
#define XB_XSUB(j)  (1280 + 64 * (j))
#define XB_XGEN(j)  (2304 + 64 * (j))
#define XB_TOP      3328
#define XB_TOPGEN   3392
#define XCD_BAR_WORDS 3456
#define XB_SPIN_CAP (1u << 20)
__device__ __forceinline__ unsigned xb_ld(unsigned* p)              { return __hip_atomic_load(p, __ATOMIC_RELAXED, __HIP_MEMORY_SCOPE_AGENT); }
__device__ __forceinline__ unsigned xb_add(unsigned* p, unsigned v) { return __hip_atomic_fetch_add(p, v, __ATOMIC_RELAXED, __HIP_MEMORY_SCOPE_AGENT); }
__device__ __forceinline__ unsigned xb_xcc_id() { return (unsigned)__builtin_amdgcn_s_getreg((3 << 11) | 20) & 0xFu; }
#define XB_SPIN(cond, bar) do { unsigned _sp = 0; while (cond) { __builtin_amdgcn_s_sleep(1); \
    if ((++_sp & 255u) == 0u) { if (xb_ld(&(bar)[XB_TMO])) break; if (_sp > XB_SPIN_CAP) { atomicAdd(&(bar)[XB_TMO], 1u); break; } } } } while (0)
struct XcdBarrier { unsigned* bar; unsigned x; volatile LAS unsigned* st; };
__device__ __forceinline__ XcdBarrier xcd_barrier_post(unsigned* bar, volatile LAS unsigned* st) {
    XcdBarrier b; b.bar = bar; b.x = xb_xcc_id(); b.st = st;
    if (threadIdx.x == 0) (void)xb_add(&bar[XB_XCNT(b.x)], 1u);
    return b;
}
__device__ __forceinline__ void xcd_barrier_complete(unsigned* bar, unsigned x, unsigned& nloc, unsigned& nx) {
    const unsigned G = gridDim.x * gridDim.y * gridDim.z;
    unsigned sum, cnt, mine, sp = 0u;
    for (;;) {
        sum = 0u; cnt = 0u; mine = 0u;
#pragma unroll
        for (unsigned j = 0; j < 16; ++j) { const unsigned c = xb_ld(&bar[XB_XCNT(j)]); sum += c; cnt += (c > 0u) ? 1u : 0u; mine = (j == x) ? c : mine; }
        if (sum == G) break;
        __builtin_amdgcn_s_sleep(1);
        if ((++sp & 255u) == 0u) { if (xb_ld(&bar[XB_TMO])) break; if (sp > XB_SPIN_CAP) { atomicAdd(&bar[XB_TMO], 1u); break; } }
    }
    nloc = mine > 0u ? mine : 1u; nx = cnt > 0u ? cnt : 1u;
}
__device__ __forceinline__ void xcd_barrier(const XcdBarrier& b) {
    asm volatile("s_waitcnt vmcnt(0)" ::: "memory");
    __syncthreads();
    if (threadIdx.x == 0) {
        unsigned* bar = b.bar;
        __builtin_amdgcn_s_waitcnt(0);
        unsigned nloc = b.st[0], nx = b.st[1];
        if (nloc == 0u) { xcd_barrier_complete(bar, b.x, nloc, nx); b.st[0] = nloc; b.st[1] = nx; }
        const unsigned old = xb_add(&bar[XB_XSUB(b.x)], 1u);
        const unsigned gen = old / nloc;
        if (old + 1u == (gen + 1u) * nloc) {
            __builtin_amdgcn_fence(__ATOMIC_RELEASE, "agent");
            asm volatile("s_waitcnt vmcnt(0)" ::: "memory");
            const unsigned og = xb_add(&bar[XB_TOP], 1u);
            const unsigned tg = og / nx;
            if (og + 1u == (tg + 1u) * nx) xb_add(&bar[XB_TOPGEN], 1u);
            else XB_SPIN(xb_ld(&bar[XB_TOPGEN]) == tg, bar);
            __builtin_amdgcn_fence(__ATOMIC_ACQUIRE, "agent");
            xb_add(&bar[XB_XGEN(b.x)], 1u);
            asm volatile("s_waitcnt vmcnt(0)" ::: "memory");
        } else {
            XB_SPIN(xb_ld(&bar[XB_XGEN(b.x)]) == gen, bar);
            __builtin_amdgcn_fence(__ATOMIC_ACQUIRE, "agent");
            asm volatile("s_waitcnt vmcnt(0)" ::: "memory");
        }
    }
    __syncthreads();
}


__device__ __forceinline__ void skinny_phase(int kind, LAS unsigned char* lds, const char* gA, const char* gB, int lda, int ldb, int K, size_t asub, size_t bsub,
                                             void* e0, void* e1, const float* e2, float* e3, float scale, const bf16_t* ppb, const bf16_t* z, int G) {
    int tid = threadIdx.x; asm volatile("" : "+v"(tid));
    const int wave = __builtin_amdgcn_readfirstlane(tid >> 6), lane = tid & 63, fr = lane & 15, fq = lane >> 4;
    LAS float* red = (LAS float*)lds;
    const int ng = K >> 6, n = ng > wave ? (ng - wave + 7) >> 3 : 0, nb = kind == 4 ? 3 : 1;
    const int orow = tid >> 4, oc4 = (tid & 15) * 4;
    for (int piece = blockIdx.x; piece < 256; piece += G) {
        const int rg = piece >> 4, cg = piece & 15, row0 = MP + rg * 32, row = row0 + orow, col = cg * 64 + oc4;
        f32x4 msum = (f32x4){0.f, 0.f, 0.f, 0.f};
        for (int b = 0; b < nb; ++b) {
            const bf16_t* ap = (const bf16_t*)(gA + (size_t)b * asub) + (size_t)(row0 + fr) * lda + wave * 64 + fq * 8;
            const bf16_t* bp = (const bf16_t*)(gB + (size_t)b * bsub) + (size_t)(cg * 64 + fr) * ldb + wave * 64 + fq * 8;
            f32x4 acc[2][4];
#pragma unroll
            for (int rb = 0; rb < 2; ++rb)
#pragma unroll
                for (int cb = 0; cb < 4; ++cb) acc[rb][cb] = (f32x4){0.f, 0.f, 0.f, 0.f};
            bf16x8 av[2][2][2], bv[2][2][4];
#define SK_LD(buf, i) do { _Pragma("unroll") for (int h = 0; h < 2; ++h) { \
        _Pragma("unroll") for (int rb = 0; rb < 2; ++rb) av[buf][h][rb] = *(const bf16x8*)(ap + (size_t)(rb * 16) * lda + (i) * 512 + h * 32); \
        _Pragma("unroll") for (int cb = 0; cb < 4; ++cb) bv[buf][h][cb] = *(const bf16x8*)(bp + (size_t)(cb * 16) * ldb + (i) * 512 + h * 32); } } while (0)
#define SK_MM(buf) do { _Pragma("unroll") for (int h = 0; h < 2; ++h) _Pragma("unroll") for (int rb = 0; rb < 2; ++rb) _Pragma("unroll") for (int cb = 0; cb < 4; ++cb) \
        acc[rb][cb] = __builtin_amdgcn_mfma_f32_16x16x32_bf16(av[buf][h][rb], bv[buf][h][cb], acc[rb][cb], 0, 0, 0); } while (0)
            if (n > 0) SK_LD(0, 0);
            for (int i = 0; i < n; i += 2) {
                if (i + 1 < n) SK_LD(1, i + 1);
                SK_MM(0);
                if (i + 2 < n) SK_LD(0, i + 2);
                if (i + 1 < n) SK_MM(1);
            }
#undef SK_LD
#undef SK_MM
#pragma unroll
            for (int rb = 0; rb < 2; ++rb)
#pragma unroll
                for (int cb = 0; cb < 4; ++cb)
#pragma unroll
                    for (int j = 0; j < 4; ++j) red[(wave * 32 + rb * 16 + fq * 4 + j) * 64 + cb * 16 + fr] = acc[rb][cb][j];
            __syncthreads();
            f32x4 v = *(const LAS f32x4*)(red + orow * 64 + oc4);
#pragma unroll
            for (int w = 1; w < 8; ++w) v += *(const LAS f32x4*)(red + (w * 32 + orow) * 64 + oc4);
            if (kind == 4) {
                const unsigned long long gw_ = *(const unsigned long long*)(z + (size_t)row * DIN + 3072 + b * 1024 + col);
                const unsigned lo = (unsigned)gw_, hi = (unsigned)(gw_ >> 32);
                msum += v * (f32x4){bf_lo(lo), bf_hi(lo), bf_lo(hi), bf_hi(hi)};
            } else msum = v;
            __syncthreads();
        }
        if (kind == 4) {
            *(unsigned long long*)((bf16_t*)e0 + (size_t)row * DIN + col) = (unsigned long long)cvt_pk_bf16(msum[0], msum[1]) | ((unsigned long long)cvt_pk_bf16(msum[2], msum[3]) << 32);
        } else if (kind == 5) {
            *(unsigned long long*)((bf16_t*)e0 + (size_t)row * D + col) = (unsigned long long)cvt_pk_bf16(msum[0], msum[1]) | ((unsigned long long)cvt_pk_bf16(msum[2], msum[3]) << 32);
        } else {
            const bf16_t* xi = (const bf16_t*)e0; bf16_t* xo = (bf16_t*)e1; const size_t off = (size_t)row * D + col;
            const unsigned long long xw = *(const unsigned long long*)(xi + off); const unsigned lo = (unsigned)xw, hi = (unsigned)(xw >> 32);
            f32x4 x = (f32x4){bf_lo(lo), bf_hi(lo), bf_lo(hi), bf_hi(hi)};
            if (kind == 1) x += msum * scale;
            else {
                const float rs = row_rstd(e2, row);
                const unsigned long long pw = *(const unsigned long long*)(ppb + off); const unsigned pl = (unsigned)pw, ph = (unsigned)(pw >> 32);
                const f32x4 p = (f32x4){bf_lo(pl), bf_hi(pl), bf_lo(ph), bf_hi(ph)};
#pragma unroll
                for (int j = 0; j < 4; ++j) x[j] += sigmoidf_(rs * msum[j]) * p[j];
            }
            *(unsigned long long*)(xo + off) = (unsigned long long)cvt_pk_bf16(x[0], x[1]) | ((unsigned long long)cvt_pk_bf16(x[2], x[3]) << 32);
            float sq = (x[0] * x[0] + x[1] * x[1]) + (x[2] * x[2] + x[3] * x[3]);
            sq += __shfl_xor(sq, 1); sq += __shfl_xor(sq, 2); sq += __shfl_xor(sq, 4); sq += __shfl_xor(sq, 8);
            if (e3 && (tid & 15) == 0) e3[(size_t)row * 16 + cg] = sq;
        }
    }
}

struct KArgs { const float* in[29]; float* out; unsigned char* ws; };
enum { I_XP = 0, I_XS, I_SCONV, I_SPOOL, I_PP, I_PS, I_GFFN1, I_WUP1, I_WDN1, I_GMIX, I_WIN, I_LNG, I_LNB, I_AWS, I_ABS, I_AOUT, I_BCONV, I_BOUT, I_CW, I_CSCALE, I_COUT, I_WO,
       I_GFFN2, I_WUP2, I_WDN2, I_GPLE, I_WPG, I_WPP, I_GFINAL };

__device__ __forceinline__ void mixer_a(const KArgs& a, int l, LAS unsigned char* lds, const bf16_t* z, bf16_t* mix, const bf16_t* wsb, int G) {
    int tid = threadIdx.x; asm volatile("" : "+v"(tid));
    const int wid = __builtin_amdgcn_readfirstlane(tid >> 6), lane = tid & 63, fr = lane & 15, fq = lane >> 4;
    LAS bf16_t* ldsV = (LAS bf16_t*)lds;
    LAS float* stats = (LAS float*)(lds + 40960);
    const float* lng = a.in[I_LNG] + l * 512; const float* lnb = a.in[I_LNB] + l * 512; const float* abs_ = a.in[I_ABS] + l * 512;
    {
        float* vout = a.out + O_VAS + (size_t)l * 128 * 4 * 512;
        const float* aws = a.in[I_AWS] + (size_t)l * 4 * 128 * 128;
        const int ch = lane * 8, g = lane >> 4;
        for (int sq = blockIdx.x * 8 + wid; sq < 128; sq += G * 8) {
            const int row0 = MP + sq * 4;
            u32x4 raw[4], uraw[4];
#pragma unroll
            for (int t = 0; t < 4; ++t) { raw[t] = *(const u32x4*)(z + (size_t)(row0 + t) * DIN + 512 + ch); uraw[t] = *(const u32x4*)(z + (size_t)(row0 + t) * DIN + ch); }
            const F8 gg = ld_f8(lng + ch), bb = ld_f8(lnb + ch);
            F8 vn[4];
#pragma unroll
            for (int t = 0; t < 4; ++t) {
                const F8 v = unpack8(raw[t]);
                float s = (v.a[0] + v.a[1]) + (v.a[2] + v.a[3]) + (v.b[0] + v.b[1]) + (v.b[2] + v.b[3]);
                float q = (v.a[0] * v.a[0] + v.a[1] * v.a[1]) + (v.a[2] * v.a[2] + v.a[3] * v.a[3]) + (v.b[0] * v.b[0] + v.b[1] * v.b[1]) + (v.b[2] * v.b[2] + v.b[3] * v.b[3]);
                s = wave_sum(s); q = wave_sum(q);
                const float mu = s * (1.0f / 512.0f), var = q * (1.0f / 512.0f) - mu * mu, rs = __builtin_amdgcn_rsqf(fmaxf(var, 0.f) + EPS);
                vn[t].a = (v.a - mu) * rs * gg.a + bb.a; vn[t].b = (v.b - mu) * rs * gg.b + bb.b;
                float* vo = vout + (size_t)(sq * 4 + t) * 512 + ch; *(f32x4*)vo = vn[t].a; *(f32x4*)(vo + 4) = vn[t].b;
            }
#pragma unroll
            for (int t = 0; t < 4; ++t) {
                const float bs = abs_[g * 128 + t];
                f32x4 m0 = (f32x4){bs, bs, bs, bs}, m1 = m0;
#pragma unroll
                for (int s_ = 0; s_ <= t; ++s_) { const float w = aws[(size_t)(g * 128 + t) * 128 + s_]; m0 += vn[s_].a * w; m1 += vn[s_].b * w; }
                const F8 uu = unpack8(uraw[t]);
                *(u32x4*)(mix + (size_t)(row0 + t) * NMIX + ch) = pack8(uu.a * m0, uu.b * m1);
            }
        }
    }
    for (int un = blockIdx.x; un < 512; un += G) {
        const int g = un & 3, cid = un >> 2, row0 = cid * 128;
        {
            u32x4 raw[16];
#pragma unroll
            for (int i = 0; i < 16; ++i) raw[i] = *(const u32x4*)(z + (size_t)(row0 + wid * 16 + i) * DIN + 512 + lane * 8);
#pragma unroll
            for (int i = 0; i < 16; ++i) {
                const int r = wid * 16 + i; const F8 v = unpack8(raw[i]);
                float s = (v.a[0] + v.a[1]) + (v.a[2] + v.a[3]) + (v.b[0] + v.b[1]) + (v.b[2] + v.b[3]);
                float q = (v.a[0] * v.a[0] + v.a[1] * v.a[1]) + (v.a[2] * v.a[2] + v.a[3] * v.a[3]) + (v.b[0] * v.b[0] + v.b[1] * v.b[1]) + (v.b[2] * v.b[2] + v.b[3] * v.b[3]);
                s = wave_sum(s); q = wave_sum(q);
                const float mu = s * (1.0f / 512.0f), var = q * (1.0f / 512.0f) - mu * mu;
                if (lane == 0) { stats[2 * r] = mu; stats[2 * r + 1] = __builtin_amdgcn_rsqf(fmaxf(var, 0.f) + EPS); }
            }
        }
        __syncthreads();
#pragma unroll
        for (int it = 0; it < 4; ++it) {
            const int item = it * NT + tid, r = item >> 4, seg = item & 15, ch = g * 128 + seg * 8;
            const F8 v = ld_bf8(z + (size_t)(row0 + r) * DIN + 512 + ch);
            const float mu = stats[2 * r], rs = stats[2 * r + 1];
            const F8 gg = ld_f8(lng + ch), bb = ld_f8(lnb + ch);
            const u32x4 w = pack8((v.a - mu) * rs * gg.a + bb.a, (v.b - mu) * rs * gg.b + bb.b);
            LAS bf16_t* dst = ldsV + (seg * 8) * 136 + r;
            dst[0 * 136] = (bf16_t)(w.x & 0xffffu); dst[1 * 136] = (bf16_t)(w.x >> 16); dst[2 * 136] = (bf16_t)(w.y & 0xffffu); dst[3 * 136] = (bf16_t)(w.y >> 16);
            dst[4 * 136] = (bf16_t)(w.z & 0xffffu); dst[5 * 136] = (bf16_t)(w.z >> 16); dst[6 * 136] = (bf16_t)(w.w & 0xffffu); dst[7 * 136] = (bf16_t)(w.w >> 16);
        }
        const int t0 = wid * 16, ksteps = (t0 + 16 + 31) >> 5;
        bf16x8 wv[4];
        const bf16_t* wrow = wsb + ((size_t)(l * 4 + g) * 128 + t0 + fr) * 128 + fq * 8;
#pragma unroll
        for (int k = 0; k < 4; ++k) wv[k] = *(const bf16x8*)(wrow + (k < ksteps ? k : 0) * 32);
        const int trow = row0 + t0 + fr;
        unsigned long long uw[8];
#pragma unroll
        for (int cb = 0; cb < 8; ++cb) uw[cb] = *(const unsigned long long*)(z + (size_t)trow * DIN + g * 128 + cb * 16 + fq * 4);
        const float bs = abs_[g * 128 + t0 + fr];
        __syncthreads();
        f32x4 acc[8];
#pragma unroll
        for (int cb = 0; cb < 8; ++cb) acc[cb] = (f32x4){0.f, 0.f, 0.f, 0.f};
#pragma unroll
        for (int k = 0; k < 4; ++k) {
            if (k < ksteps) {
#pragma unroll
                for (int cb = 0; cb < 8; ++cb) {
                    const bf16x8 vv = *(const LAS bf16x8*)(ldsV + (cb * 16 + fr) * 136 + k * 32 + fq * 8);
                    acc[cb] = __builtin_amdgcn_mfma_f32_16x16x32_bf16(vv, wv[k], acc[cb], 0, 0, 0);
                }
            }
        }
#pragma unroll
        for (int cb = 0; cb < 8; ++cb) {
            const unsigned lo = (unsigned)uw[cb], hi = (unsigned)(uw[cb] >> 32);
            const unsigned o0 = cvt_pk_bf16(bf_lo(lo) * (acc[cb][0] + bs), bf_hi(lo) * (acc[cb][1] + bs)), o1 = cvt_pk_bf16(bf_lo(hi) * (acc[cb][2] + bs), bf_hi(hi) * (acc[cb][3] + bs));
            *(unsigned long long*)(mix + (size_t)trow * NMIX + g * 128 + cb * 16 + fq * 4) = (unsigned long long)o0 | ((unsigned long long)o1 << 32);
        }
        __syncthreads();
    }
}

__device__ __forceinline__ void mixer_bc(const KArgs& a, int l, const bf16_t* z, bf16_t* mix, int G) {
    const float* sconv = a.in[I_SCONV] + (size_t)l * 128 * 2 * 512;
    const float* spool = a.in[I_SPOOL] + (size_t)l * 128 * 15 * 512;
    const float* bconv = a.in[I_BCONV] + l * 3 * 512;
    float* oconvp = a.out + O_CONVP + (size_t)l * 8 * 2 * 512;
    float* oconvs = a.out + O_CONVS + (size_t)l * 128 * 2 * 512;
    float* opoolp = a.out + O_POOLP + (size_t)l * 8 * 15 * 512;
    float* opools = a.out + O_POOLS + (size_t)l * 128 * 15 * 512;
    int tid = threadIdx.x; asm volatile("" : "+v"(tid));
    for (int idx = blockIdx.x * NT + tid; idx < (MP / 2) * 64; idx += G * NT) {
        const int m = (idx >> 6) * 2, seg = idx & 63, ch = seg * 8;
        const bf16_t* zr = z + (size_t)m * DIN;
        const int gi = seg >> 4, win = 2 << gi;
        const F8 w0 = ld_f8(bconv + ch), w1 = ld_f8(bconv + 512 + ch), w2 = ld_f8(bconv + 1024 + ch);
        const int sq = m >> 11, t0 = m & 2047;
        const float k2 = t0 >= 2 ? 1.f : 0.f;
        const bf16_t* zm1 = t0 >= 2 ? zr - DIN : zr; const bf16_t* zm2 = t0 >= 2 ? zr - 2 * DIN : zr;
        const F8 gA_ = ld_bf8(zm2 + 1536 + ch), xA_ = ld_bf8(zm2 + 2048 + ch), gB_ = ld_bf8(zm1 + 1536 + ch), xB_ = ld_bf8(zm1 + 2048 + ch);
        const F8 gC_ = ld_bf8(zr + 1536 + ch), xC_ = ld_bf8(zr + 2048 + ch), gD_ = ld_bf8(zr + DIN + 1536 + ch), xD_ = ld_bf8(zr + DIN + 2048 + ch);
        const F8 bg0 = ld_bf8(zr + 1024 + ch), bg1 = ld_bf8(zr + DIN + 1024 + ch);
        F8 r[17];
#pragma unroll
        for (int k = 0; k < 17; ++k) { const bool ok = (k <= win) && (k <= t0 + 1); r[k] = ld_bf8((ok ? zr + DIN - (size_t)k * DIN : zr) + 2560 + ch); }
        const f32x4 cAa = gA_.a * xA_.a * k2, cAb = gA_.b * xA_.b * k2, cBa = gB_.a * xB_.a * k2, cBb = gB_.b * xB_.b * k2;
        const f32x4 cCa = gC_.a * xC_.a, cCb = gC_.b * xC_.b, cDa = gD_.a * xD_.a, cDb = gD_.b * xD_.b;
        *(u32x4*)(mix + (size_t)m * NMIX + 512 + ch) = pack8(bg0.a * (cAa * w0.a + cBa * w1.a + cCa * w2.a), bg0.b * (cAb * w0.b + cBb * w1.b + cCb * w2.b));
        *(u32x4*)(mix + (size_t)(m + 1) * NMIX + 512 + ch) = pack8(bg1.a * (cBa * w0.a + cCa * w1.a + cDa * w2.a), bg1.b * (cBb * w0.b + cCb * w1.b + cDb * w2.b));
        if (t0 == 2046) { float* o = oconvp + (size_t)(sq * 2) * 512 + ch; *(f32x4*)o = cCa; *(f32x4*)(o + 4) = cCb; *(f32x4*)(o + 512) = cDa; *(f32x4*)(o + 516) = cDb; }
        f32x4 s1a = r[0].a, s1b = r[0].b, s0a = r[1].a, s0b = r[1].b;
#pragma unroll
        for (int k = 1; k < 17; ++k) {
            const float wt1 = (k < win && k <= t0 + 1) ? 1.f : 0.f, wt0 = (k >= 2 && k <= win && k - 1 <= t0) ? 1.f : 0.f;
            s1a += r[k].a * wt1; s1b += r[k].b * wt1; s0a += r[k].a * wt0; s0b += r[k].b * wt0;
        }
        const float inv0 = 1.0f / (float)(win < t0 + 1 ? win : t0 + 1), inv1 = 1.0f / (float)(win < t0 + 2 ? win : t0 + 2);
        *(u32x4*)(mix + (size_t)m * NMIX + 1024 + ch) = pack8(s0a * inv0 - r[1].a, s0b * inv0 - r[1].b);
        *(u32x4*)(mix + (size_t)(m + 1) * NMIX + 1024 + ch) = pack8(s1a * inv1 - r[0].a, s1b * inv1 - r[0].b);
        if (t0 + 1 >= 2033) {
            if (t0 >= 2033) { float* o = opoolp + (size_t)(sq * 15 + (t0 - 2033)) * 512 + ch; *(f32x4*)o = r[1].a; *(f32x4*)(o + 4) = r[1].b; }
            float* o = opoolp + (size_t)(sq * 15 + (t0 + 1 - 2033)) * 512 + ch; *(f32x4*)o = r[0].a; *(f32x4*)(o + 4) = r[0].b;
        }
    }
    for (int idx = blockIdx.x * NT + tid; idx < MS * 64; idx += G * NT) {
        const int m = MP + (idx >> 6), seg = idx & 63, ch = seg * 8;
        const bf16_t* zr = z + (size_t)m * DIN;
        const int gi = seg >> 4, win = 2 << gi;
        const F8 w0 = ld_f8(bconv + ch), w1 = ld_f8(bconv + 512 + ch), w2 = ld_f8(bconv + 1024 + ch);
        {
            const int sq = (m - MP) >> 2, t = (m - MP) & 3;
            F8 c2, c1, c0;
            { const F8 cg_ = ld_bf8(zr + 1536 + ch), xb_ = ld_bf8(zr + 2048 + ch); c2.a = cg_.a * xb_.a; c2.b = cg_.b * xb_.b; }
            if (t >= 1) { const F8 cg_ = ld_bf8(zr - DIN + 1536 + ch), xb_ = ld_bf8(zr - DIN + 2048 + ch); c1.a = cg_.a * xb_.a; c1.b = cg_.b * xb_.b; }
            else c1 = ld_f8(sconv + (size_t)(sq * 2 + 1) * 512 + ch);
            if (t >= 2) { const F8 cg_ = ld_bf8(zr - 2 * DIN + 1536 + ch), xb_ = ld_bf8(zr - 2 * DIN + 2048 + ch); c0.a = cg_.a * xb_.a; c0.b = cg_.b * xb_.b; }
            else c0 = ld_f8(sconv + (size_t)(sq * 2 + t) * 512 + ch);
            {
                const F8 bg = ld_bf8(zr + 1024 + ch);
                const f32x4 ya = bg.a * (c0.a * w0.a + c1.a * w1.a + c2.a * w2.a), yb = bg.b * (c0.b * w0.b + c1.b * w1.b + c2.b * w2.b);
                *(u32x4*)(mix + (size_t)m * NMIX + 512 + ch) = pack8(ya, yb);
            }
            if (t >= 2) { float* o = oconvs + (size_t)(sq * 2 + (t - 2)) * 512 + ch; *(f32x4*)o = c2.a; *(f32x4*)(o + 4) = c2.b; }
            const F8 xt = ld_bf8(zr + 2560 + ch);
            f32x4 s0 = xt.a, s1 = xt.b;
            for (int i = 1; i < win; ++i) {
                const int tp = t - i;
                if (tp >= 0) { const F8 v = ld_bf8(zr - (size_t)i * DIN + 2560 + ch); s0 += v.a; s1 += v.b; }
                else { const F8 v = ld_f8(spool + (size_t)(sq * 15 + 15 + tp) * 512 + ch); s0 += v.a; s1 += v.b; }
            }
            const float inv = 1.0f / (float)win;
            *(u32x4*)(mix + (size_t)m * NMIX + 1024 + ch) = pack8(s0 * inv - xt.a, s1 * inv - xt.b);
            float* o = opools + (size_t)(sq * 15 + 11 + t) * 512 + ch; *(f32x4*)o = xt.a; *(f32x4*)(o + 4) = xt.b;
            if (t == 0) {
                for (int j = 0; j < 11; ++j) { const F8 v = ld_f8(spool + (size_t)(sq * 15 + j + 4) * 512 + ch); float* oj = opools + (size_t)(sq * 15 + j) * 512 + ch; *(f32x4*)oj = v.a; *(f32x4*)(oj + 4) = v.b; }
            }
        }
    }
}

__global__ void __launch_bounds__(NT, 2) fwd_kernel(KArgs a) {
    extern __shared__ __attribute__((aligned(16))) unsigned char lds_raw[];
    LAS unsigned char* lds = (LAS unsigned char*)lds_raw;
    cg::grid_group grid = cg::this_grid();
    const int G = gridDim.x, bx = blockIdx.x;
    const int ngw = G * 8, ngt = G * NT;
    unsigned char* ws = a.ws;
    float* xf = a.out;
    float* ssb = (float*)(ws + WS_SS);
    bf16_t* wsb = (bf16_t*)(ws + WS_WSB);
    unsigned char* wa = (unsigned char*)a.out;
    bf16_t* xb = (bf16_t*)(ws + WS_XB);
    bf16_t* mix = (bf16_t*)(ws + WS_MIX);
    bf16_t* pb = (bf16_t*)(ws + WS_MIX);
    bf16_t* xbn = (bf16_t*)(ws + WS_MIX + XBN_OFF);
    bf16_t* big = (bf16_t*)(ws + WS_BIG);
    bf16_t* ppb = (bf16_t*)(ws + WS_BIG + PP_OFF);
#define SSB(l, i) (ssb + (size_t)((l) * 4 + (i)) * (M * 16))

    if (PHASE_MASK & 1) {
    int tid_o = threadIdx.x; asm volatile("" : "+v"(tid_o));
    const int lane = tid_o & 63, wave = __builtin_amdgcn_readfirstlane(tid_o >> 6);
    const int gw = bx * 8 + wave, gt = bx * NT + tid_o;
    LAS float* scr = (LAS float*)(lds + wave * 16384);
    for (int m0 = gw; m0 < M; m0 += 3 * ngw) {
        f32x4 v[3][4]; float s[3];
#pragma unroll
        for (int r = 0; r < 3; ++r) {
            const int m = (m0 + r * ngw) < M ? m0 + r * ngw : m0;
            const float* src = m < MP ? a.in[I_XP] + (size_t)m * D : a.in[I_XS] + (size_t)(m - MP) * D;
#pragma unroll
            for (int j = 0; j < 4; ++j) v[r][j] = *(const f32x4*)(src + j * 256 + lane * 4);
        }
#pragma unroll
        for (int r = 0; r < 3; ++r) {
            float t = 0.f;
#pragma unroll
            for (int j = 0; j < 4; ++j) t += (v[r][j][0] * v[r][j][0] + v[r][j][1] * v[r][j][1]) + (v[r][j][2] * v[r][j][2] + v[r][j][3] * v[r][j][3]);
            s[r] = wave_sum(t);
        }
#pragma unroll
        for (int r = 0; r < 3; ++r) {
            const int m = m0 + r * ngw;
            if (m < M) {
#pragma unroll
                for (int j = 0; j < 4; ++j)
                    *(unsigned long long*)(xb + (size_t)m * D + j * 256 + lane * 4) = (unsigned long long)cvt_pk_bf16(v[r][j][0], v[r][j][1]) | ((unsigned long long)cvt_pk_bf16(v[r][j][2], v[r][j][3]) << 32);
                if (lane < 16) SSB(0, 0)[(size_t)m * 16 + lane] = lane == 0 ? s[r] : 0.f;
            }
        }
    }
    for (int i = gt; i < 2 * 4 * 128 * 128; i += ngt) { const int tt = (i >> 7) & 127, s_ = i & 127; const float v = a.in[I_AWS][i]; wsb[i] = (bf16_t)(cvt_pk_bf16(s_ <= tt ? v : 0.f, 0.f) & 0xffffu); }
    convert_job(1, a.in[I_WUP1], D, 2 * FF, a.in[I_GFFN1], (bf16_t*)(wa + WA_UP1), D, 0, gw, ngw, scr, lane);
    }
    volatile LAS unsigned* bst = (volatile LAS unsigned*)(lds + RING_BYTES);
    if (threadIdx.x == 0) { bst[0] = 0u; bst[1] = 0u; }
    const XcdBarrier xbar = xcd_barrier_post((unsigned*)(ws + WS_BAR), bst);
    if (ws == nullptr) grid.sync();

#pragma unroll 1
    for (int st = 0; st <= 20; ++st) {
        const int l = st >= 10 ? 1 : 0, s = st - 10 * l;
        if (s != 8) { xcd_barrier(xbar); if (PROBE == 4) xcd_barrier(xbar); }
        int tid_o = threadIdx.x; asm volatile("" : "+v"(tid_o));
        const int lane = tid_o & 63, wave = __builtin_amdgcn_readfirstlane(tid_o >> 6);
        if (s == 10) {
            if ((PHASE_MASK >> 11) & 1) {
            const int gw = bx * 8 + wave;
            const float* gf = a.in[I_GFINAL];
            for (int m0 = gw; m0 < M; m0 += 3 * ngw) {
                unsigned long long w[3][4]; f32x4 gg[4];
#pragma unroll
                for (int r = 0; r < 3; ++r) { const int m = (m0 + r * ngw) < M ? m0 + r * ngw : m0;
#pragma unroll
                    for (int j = 0; j < 4; ++j) w[r][j] = *(const unsigned long long*)(xbn + (size_t)m * D + j * 256 + lane * 4); }
#pragma unroll
                for (int j = 0; j < 4; ++j) gg[j] = *(const f32x4*)(gf + j * 256 + lane * 4);
#pragma unroll
                for (int r = 0; r < 3; ++r) {
                    const int m = m0 + r * ngw;
                    f32x4 v[4]; float sm = 0.f;
#pragma unroll
                    for (int j = 0; j < 4; ++j) { const unsigned lo = (unsigned)w[r][j], hi = (unsigned)(w[r][j] >> 32);
                        v[j] = (f32x4){bf_lo(lo), bf_hi(lo), bf_lo(hi), bf_hi(hi)}; sm += (v[j][0] * v[j][0] + v[j][1] * v[j][1]) + (v[j][2] * v[j][2] + v[j][3] * v[j][3]); }
                    sm = wave_sum(sm);
                    const float rs = 1.0f / sqrtf(sm * (1.0f / 1024.0f) + EPS);
                    if (m < M) {
#pragma unroll
                        for (int j = 0; j < 4; ++j) *(f32x4*)(xf + (size_t)m * D + j * 256 + lane * 4) = v[j] * rs * gg[j];
                    }
                }
            }
            }
            continue;
        }
        int kind = -1, sync = 1, nj = 0;
        const char* gA = nullptr; const char* gB = nullptr; int lda = 0, ldb = 0, gK = 0, gN = 0, nsub = 1; size_t asub = 0, bsub = 0;
        void* e0 = nullptr; void* e1 = nullptr; const float* e2 = nullptr; float* e3 = nullptr; float scale = 0.f;
        switch (s) {
        case 0: nj = l == 0 ? 2 : 1;
                kind = 0; gA = (const char*)(l == 0 ? xb : xbn); gB = (const char*)(wa + WA_UP1); lda = D; ldb = D; gK = D; gN = 2 * FF; e0 = big; e2 = SSB(l, 0); break;
        case 1: kind = 1; gA = (const char*)big; gB = (const char*)(wa + WA_DN1); lda = FF; ldb = FF; gK = FF; gN = D; e0 = (void*)(l == 0 ? xb : xbn); e1 = xb; e3 = SSB(l, 1); scale = 0.5f; break;
        case 2: nj = l == 0 ? 10 : 8;
                kind = 2; gA = (const char*)xb; gB = (const char*)(wa + WA_IN); lda = D; ldb = D; gK = D; gN = DIN; e0 = big; e2 = SSB(l, 1); break;
        case 3: kind = 3; break;
        case 4: kind = 4; gA = (const char*)mix; gB = (const char*)(wa + WA_ABC); lda = NMIX; ldb = 512; gK = 512; gN = D; nsub = 6; asub = 512 * 2; bsub = (size_t)1024 * 512 * 2; e0 = big; break;
        case 5: kind = 1; gA = (const char*)big; gB = (const char*)(wa + WA_O); lda = DIN; ldb = D; gK = D; gN = D; e0 = xb; e1 = xb; e3 = SSB(l, 2); scale = 1.0f; break;
        case 6: nj = 1;
                kind = 0; gA = (const char*)xb; gB = (const char*)(wa + WA_UP2); lda = D; ldb = D; gK = D; gN = 2 * FF; e0 = big; e2 = SSB(l, 2); break;
        case 7: kind = 1; sync = 0; gA = (const char*)big; gB = (const char*)(wa + WA_DN2); lda = FF; ldb = FF; gK = FF; gN = D; e0 = xb; e1 = xb; e3 = SSB(l, 3); scale = 0.5f; break;
        case 8: kind = 5; gA = (const char*)pb; gB = (const char*)(wa + WA_PROJ); lda = DPLE; ldb = DPLE; gK = DPLE; gN = D; e0 = ppb; break;
        default: kind = 6; gA = (const char*)xb; gB = (const char*)(wa + WA_PG); lda = D; ldb = D; gK = D; gN = D; e0 = xb; e1 = xbn; e2 = SSB(l, 3); e3 = l == 0 ? SSB(1, 0) : nullptr; break;
        }
        if ((PHASE_MASK >> (s + 1)) & 1) {
        if (nj > 0) {
            const int nwg = (M / 256) * (gN / 256), rem = nwg % G;
            if (bx >= rem) {
                const int gw = (bx - rem) * 8 + wave, ngw_l = (G - rem) * 8;
                int total = 0;
                for (int ji = 0; ji < nj; ++ji) { const int id = s == 0 ? (l == 0 ? 1 + ji : 2) : (s == 2 ? (ji < 8 ? 3 + ji : ji - 8) : 11); total += job_items(id); }
                for (int rp = 0; rp < (PROBE == 3 ? 2 : 1); ++rp)
                for (int it = gw; it < total; it += ngw_l) {
                    int r = it, id = 0, jl = l;
                    for (int ji = 0; ji < nj; ++ji) { id = s == 0 ? (l == 0 ? 1 + ji : 2) : (s == 2 ? (ji < 8 ? 3 + ji : ji - 8) : 11); jl = (s == 2 && ji >= 8) ? 1 : l; const int c = job_items(id); if (r < c) break; r -= c; }
                    if (id == 5) {
                        const float* cw = a.in[I_CW] + (size_t)jl * 4 * 128 * 128; const float* cs = a.in[I_CSCALE] + jl * 512; const float* co = a.in[I_COUT] + (size_t)jl * 512 * D;
                        bf16_t* wdst = (bf16_t*)(wa + WA_ABC);
                        const int i = r * 64 + lane;
                        const int k0 = (i >> 10) * 8, n = i & 1023, gq = k0 >> 7;
                        const float* cwr = cw + (size_t)k0 * 128; const float* csr = cs + gq * 128; const float* cor = co + (size_t)(gq * 128) * D + n;
                        float sm[8];
#pragma unroll
                        for (int j = 0; j < 8; ++j) sm[j] = 0.f;
#pragma unroll 8
                        for (int d = 0; d < 128; ++d) { const float v = csr[d] * cor[(size_t)d * D];
#pragma unroll
                            for (int j = 0; j < 8; ++j) sm[j] += cwr[j * 128 + d] * v; }
                        u32x4 o; o.x = cvt_pk_bf16(sm[0], sm[1]); o.y = cvt_pk_bf16(sm[2], sm[3]); o.z = cvt_pk_bf16(sm[4], sm[5]); o.w = cvt_pk_bf16(sm[6], sm[7]);
                        *(u32x4*)(wdst + (size_t)(2048 + n) * 512 + k0) = o;
                    } else if (id == 11) {
                        const float* ppr = a.in[I_PP] + (size_t)jl * MP * DPLE; const float* psm = a.in[I_PS] + (size_t)jl * MS * DPLE;
#pragma unroll
                        for (int q = 0; q < 4; ++q) {
                            const size_t e = ((size_t)r * 256 + q * 64 + lane) * 8; const float* src = e < (size_t)MP * DPLE ? ppr + e : psm + (e - (size_t)MP * DPLE);
                            const F8 v = ld_f8(src); *(u32x4*)(pb + e) = pack8(v.a, v.b);
                        }
                    } else {
                        const float* jW; const float* jG = nullptr; unsigned char* jD; int jK, jN, jL, jR = 0, jM = 0;
                        switch (id) {
                        case 0: jW = a.in[I_WUP1] + (size_t)jl * D * 2 * FF; jG = a.in[I_GFFN1] + jl * D; jD = wa + WA_UP1; jK = D; jN = 2 * FF; jL = D; jM = 1; break;
                        case 1: jW = a.in[I_WDN1] + (size_t)jl * FF * D; jD = wa + WA_DN1; jK = FF; jN = D; jL = FF; break;
                        case 2: jW = a.in[I_WIN] + (size_t)jl * D * DIN; jG = a.in[I_GMIX] + jl * D; jD = wa + WA_IN; jK = D; jN = DIN; jL = D; break;
                        case 3: jW = a.in[I_AOUT] + (size_t)jl * 512 * D; jD = wa + WA_ABC; jK = 512; jN = D; jL = 512; break;
                        case 4: jW = a.in[I_BOUT] + (size_t)jl * 512 * D; jD = wa + WA_ABC; jK = 512; jN = D; jL = 512; jR = 1024; break;
                        case 6: jW = a.in[I_WO] + (size_t)jl * D * D; jD = wa + WA_O; jK = D; jN = D; jL = D; break;
                        case 7: jW = a.in[I_WUP2] + (size_t)jl * D * 2 * FF; jG = a.in[I_GFFN2] + jl * D; jD = wa + WA_UP2; jK = D; jN = 2 * FF; jL = D; jM = 1; break;
                        case 8: jW = a.in[I_WDN2] + (size_t)jl * FF * D; jD = wa + WA_DN2; jK = FF; jN = D; jL = FF; break;
                        case 9: jW = a.in[I_WPP] + (size_t)jl * DPLE * D; jD = wa + WA_PROJ; jK = DPLE; jN = D; jL = DPLE; break;
                        default: jW = a.in[I_WPG] + (size_t)jl * D * D; jG = a.in[I_GPLE] + jl * D; jD = wa + WA_PG; jK = D; jN = D; jL = D; break;
                        }
                        convert_item(jM, jW, jN, jG, (bf16_t*)jD, jL, jR, r, lane);
                    }
                }
            }
        }
        for (int rb = 0; rb < (((PROBE == 1 && s == 0) || (PROBE == 2 && s == 3) || (PROBE == 5 && (s == 1 || s == 7)) || (PROBE == 6 && s == 4) || (PROBE == 7 && s == 5) || (PROBE == 11 && s == 7)) ? 2 : 1); ++rb) {
        if (PROBE >= 5 && rb == 1) scale = 0.f;
        if (kind == 3) {
            for (int q = 0; q < (PROBE == 8 ? 2 : 1); ++q) mixer_a(a, l, lds, big, mix, wsb, G);
            for (int q = 0; q < (PROBE == 9 ? 2 : 1); ++q) mixer_bc(a, l, big, mix, G);
        } else {
            const bool narrow = (kind == 1 || kind >= 4);
            pg8::Gemm g{gA, gB, lda, ldb, gK, asub, bsub}; pg8::StaticOrder S; S.init(narrow ? MP : M, gN, G, bx, nsub);
            switch (kind) {
            case 0: { EpiSwiglu E{(bf16_t*)e0, e2, lds}; pg8::gemm_phase(lds, g, S, E); } break;
            case 1: { EpiResid E{(const bf16_t*)e0, (bf16_t*)e1, e3, scale}; pg8::gemm_phase(lds, g, S, E); } break;
            case 2: { EpiZin E{(bf16_t*)e0, e2, lds}; pg8::gemm_phase(lds, g, S, E); } break;
            case 4: { EpiMergeH E{(unsigned char*)e0}; pg8::gemm_phase<EpiMergeH, true>(lds, g, S, E); } break;
            case 5: { EpiPP E{(bf16_t*)e0}; pg8::gemm_phase(lds, g, S, E); } break;
            default: { EpiPle E{(const bf16_t*)e0, (bf16_t*)e1, ppb, e2, e3, lds}; pg8::gemm_phase(lds, g, S, E); } break;
            }
            if (narrow) for (int q = 0; q < (((PROBE == 10 && kind != 6) || (PROBE == 12 && s == 7)) ? 2 : 1); ++q) skinny_phase(kind, lds, gA, gB, lda, ldb, gK, asub, bsub, e0, e1, e2, e3, q ? 0.f : scale, ppb, big, G);
        }
        }
        }
    }

}

extern "C" void kernel_launch(void* const* d_in, const int* in_sizes, int n_in, void* d_out, int out_size, void* d_ws, size_t ws_size, hipStream_t stream) {
    static int grid = 0;
    if (grid == 0) {
        if (n_in != 29 || ws_size < WS_END) { fprintf(stderr, "kernel_launch: need 29 inputs and >= %zu bytes of workspace; got %d, %zu\n", (size_t)WS_END, n_in, ws_size); grid = -1; return; }
        int dev = 0, cus = 0, per_cu = 0;
        if (hipGetDevice(&dev) != hipSuccess || hipDeviceGetAttribute(&cus, hipDeviceAttributeMultiprocessorCount, dev) != hipSuccess) { grid = -1; return; }
        if (hipFuncSetAttribute((const void*)fwd_kernel, hipFuncAttributeMaxDynamicSharedMemorySize, LDS_BYTES) != hipSuccess) { fprintf(stderr, "kernel_launch: hipFuncSetAttribute failed\n"); grid = -1; return; }
        if (hipOccupancyMaxActiveBlocksPerMultiprocessor(&per_cu, (const void*)fwd_kernel, NT, LDS_BYTES) != hipSuccess || per_cu < 1) { fprintf(stderr, "kernel_launch: occupancy query says %d\n", per_cu); grid = -1; return; }
        grid = cus * per_cu;
    }
    if (grid < 0) return;
    if (hipMemsetAsync((char*)d_ws + WS_BAR, 0, XCD_BAR_WORDS * 4, stream) != hipSuccess) { fprintf(stderr, "kernel_launch: memset failed\n"); return; }
    KArgs a{};
    for (int i = 0; i < 29; ++i) a.in[i] = (const float*)d_in[i];
    a.out = (float*)d_out; a.ws = (unsigned char*)d_ws;
    void* args[] = {&a};
    hipError_t e = hipLaunchCooperativeKernel((const void*)fwd_kernel, dim3(grid), dim3(NT), args, LDS_BYTES, stream);
    if (e != hipSuccess) fprintf(stderr, "cooperative launch failed: %s (grid %d)\n", hipGetErrorString(e), grid);
}
```

```cpp
#include <hip/hip_runtime.h>
#include <hip/hip_cooperative_groups.h>
#include <cstdio>
#include <cstdint>
namespace cg = cooperative_groups;

#define LAS __attribute__((address_space(3)))
typedef unsigned short bf16_t;
typedef short bf16x8 __attribute__((ext_vector_type(8)));
typedef float f32x4 __attribute__((ext_vector_type(4)));
typedef unsigned u32x4 __attribute__((ext_vector_type(4)));

constexpr int MP = 16384, MS = 512, M = MP + MS;
constexpr int D = 1024, FF = 2816, DIN = 6144, DPLE = 256;
constexpr int NMIX = 1536;
constexpr float EPS = 1e-6f;
constexpr int NT = 512;

constexpr size_t O_CONVP = 17301504, O_CONVS = 17317888, O_POOLP = 17580032, O_POOLS = 17702912, O_VAS = 19668992;

constexpr size_t MiB = 1u << 20;
constexpr size_t WS_SS = 0;
constexpr size_t SS_BUF = (size_t)M * 16 * 4;
constexpr size_t WS_WSB = 9 * MiB;
constexpr size_t WS_BAR = 9 * MiB + 512 * 1024;
constexpr size_t WS_W0 = 10 * MiB, WS_W1 = 22 * MiB;
constexpr size_t WS_XB = 34 * MiB;
constexpr size_t WS_MIX = 67 * MiB;
constexpr size_t WS_BIG = 117 * MiB;
constexpr size_t WS_END = WS_BIG + (size_t)M * DIN * 2;
constexpr size_t XBN_OFF = 16 * MiB, PP_OFF = 100 * MiB;
constexpr size_t WA_UP1 = 0, WA_DN1 = 12 * MiB, WA_IN = 18 * MiB, WA_ABC = 30 * MiB, WA_O = 33 * MiB, WA_UP2 = 35 * MiB, WA_DN2 = 47 * MiB, WA_PROJ = 53 * MiB, WA_PG = 54 * MiB;

#ifndef PROBE
#define PROBE 0
#endif
#ifndef PHASE_MASK
#define PHASE_MASK 0xFFFF
#endif
constexpr int RING_BYTES = 131072;
constexpr int LDS_BYTES = 147456;

__device__ __forceinline__ unsigned cvt_pk_bf16(float lo, float hi) { unsigned r; asm volatile("v_cvt_pk_bf16_f32 %0, %1, %2" : "=v"(r) : "v"(lo), "v"(hi)); return r; }
__device__ __forceinline__ float bf_lo(unsigned w) { return __builtin_bit_cast(float, w << 16); }
__device__ __forceinline__ float bf_hi(unsigned w) { return __builtin_bit_cast(float, w & 0xffff0000u); }
struct F8 { f32x4 a, b; };
__device__ __forceinline__ F8 unpack8(u32x4 w) { F8 r; r.a = (f32x4){bf_lo(w.x), bf_hi(w.x), bf_lo(w.y), bf_hi(w.y)}; r.b = (f32x4){bf_lo(w.z), bf_hi(w.z), bf_lo(w.w), bf_hi(w.w)}; return r; }
__device__ __forceinline__ u32x4 pack8(f32x4 a, f32x4 b) { u32x4 w; w.x = cvt_pk_bf16(a[0], a[1]); w.y = cvt_pk_bf16(a[2], a[3]); w.z = cvt_pk_bf16(b[0], b[1]); w.w = cvt_pk_bf16(b[2], b[3]); return w; }
__device__ __forceinline__ F8 ld_bf8(const bf16_t* p) { return unpack8(*(const u32x4*)p); }
__device__ __forceinline__ F8 ld_f8(const float* p) { F8 r; r.a = *(const f32x4*)p; r.b = *(const f32x4*)(p + 4); return r; }
__device__ __forceinline__ float sigmoidf_(float x) { return __builtin_amdgcn_rcpf(1.0f + __builtin_amdgcn_exp2f(-1.4426950408889634f * x)); }
__device__ __forceinline__ float siluf_(float x) { return x * sigmoidf_(x); }
__device__ __forceinline__ float gelu_tanh_(float x) { const float y = 0.7978845608028654f * (x + 0.044715f * x * x * x); return x * sigmoidf_(2.0f * y); }
__device__ __forceinline__ float wave_sum(float v) {
#pragma unroll
    for (int o = 1; o < 64; o <<= 1) v += __shfl_xor(v, o);
    return v;
}
__device__ __forceinline__ float row_rstd(const float* ss, int row) {
    const f32x4* p = (const f32x4*)(ss + (size_t)row * 16);
    const f32x4 a = p[0], b = p[1], c = p[2], d = p[3];
    const f32x4 s = (a + b) + (c + d);
    const float t = (s[0] + s[1]) + (s[2] + s[3]);
    return __builtin_amdgcn_rsqf(t * (1.0f / 1024.0f) + EPS);
}

namespace pg8 {
constexpr int BM = 256, BK = 64, HALF = 128, HTB = HALF * BK * 2, NXCD = 8, WGM = 8;
__host__ __device__ __forceinline__ int lds_byte(int r, int c) { const int st = (r >> 4) * 2 + (c >> 5), rr = r & 15, cc = c & 31, ob = rr * 64 + cc * 2; return st * 1024 + (ob ^ (((ob >> 9) & 1) << 5)); }
__host__ __device__ __forceinline__ void stage_rc(int b, int& R, int& C) { const int st = b / 1024, sb = b % 1024, swz = sb ^ (((sb >> 9) & 1) << 5); R = (st >> 1) * 16 + swz / 64; C = (st & 1) * 32 + (swz % 64) / 2; }
__host__ __device__ __forceinline__ int perm32(int rho) { const int n = rho >> 4, i = rho & 15; return 8 * (i >> 2) + 4 * n + (i & 3); }

struct Unit { int pm, pn, sub; };
struct Gemm { const char* A; const char* Bt; int lda, ldb, K; size_t a_sub, b_sub; };

struct StaticOrder {
    int nM, nN, nwg, G, c, nsub;
    __device__ void init(int M_, int N_, int G_, int c_, int nsub_) { nM = M_ / BM; nN = N_ / BM; nwg = nM * nN; G = G_; c = c_; nsub = nsub_; }
    __device__ bool next(int i, Unit& u) const {
        const int ib = i / nsub; u.sub = i - ib * nsub;
        const long L = (long)ib * G + c; if (L >= nwg) return false;
        int wgid = (int)L; { const int q = nwg / NXCD, r = nwg % NXCD, xcd = wgid % NXCD, off = wgid / NXCD; wgid = (xcd < r ? xcd * (q + 1) : r * (q + 1) + (xcd - r) * q) + off; }
        const int nig = WGM * nN, gid = wgid / nig, fm = gid * WGM, gsz = (nM - fm) < WGM ? (nM - fm) : WGM;
        u.pm = fm + ((wgid % nig) % gsz); u.pn = (wgid % nig) / gsz; return true;
    }
};

template <class Epi, bool HALFN = false>
__device__ __forceinline__ void gemm_phase(LAS unsigned char* lds, const Gemm g, const StaticOrder& S, const Epi& E) {
    int tid = threadIdx.x; asm volatile("" : "+v"(tid));
    const int wid = __builtin_amdgcn_readfirstlane(tid >> 6), lane = tid & 63, wr = wid >> 2, wc = wid & 3, fr = lane & 15, fq = lane >> 4;
    const int K = g.K, nt = K / BK;
    unsigned voffA[2], voffB[2];
#pragma unroll
    for (int i = 0; i < 2; ++i) { int R, C; stage_rc(tid * 16 + i * 8192, R, C); const int Rb = (R & ~31) + perm32(R & 31);
        voffA[i] = (unsigned)(R * g.lda + C) * 2u; voffB[i] = (unsigned)(Rb * g.ldb + C) * 2u; }
    const size_t kstep = (size_t)(BK * 2);
    const size_t hstepA = (size_t)HALF * g.lda * 2, hstepB = (size_t)HALF * g.ldb * 2;
    const size_t tstepA = 2 * hstepA, tstepB = 2 * hstepB;
    const unsigned ldsw = (unsigned)wid * 1024u;
    const int aoff = lds_byte(wr * 64 + fr, fq * 8), boff = lds_byte(wc * 32 + fr, fq * 8);
#define PG8_SA(b, h) (((b) * 2 + (h)) * HTB)
#define PG8_SB(b, h) ((4 + (b) * 2 + (h)) * HTB)
#define PG8_STAGE(bufoff, gbase, voff) do { _Pragma("unroll") for (int _i = 0; _i < 2; ++_i) \
        __builtin_amdgcn_global_load_lds((const unsigned*)((const char*)(gbase) + (voff)[_i]), (LAS unsigned*)(lds + (bufoff) + ldsw + _i * 8192), 16, 0, 0); } while (0)
#define PG8_LDA(dst, b, h) do { _Pragma("unroll") for (int m = 0; m < 4; ++m) _Pragma("unroll") for (int k = 0; k < 2; ++k) dst[m][k] = *(const LAS bf16x8*)(lds + PG8_SA(b, h) + aoff + m * 2048 + k * 1024); } while (0)
#define PG8_LDB(dst, b, h) do { _Pragma("unroll") for (int n = 0; n < 2; ++n) _Pragma("unroll") for (int k = 0; k < 2; ++k) dst[n][k] = *(const LAS bf16x8*)(lds + PG8_SB(b, h) + boff + n * 2048 + k * 1024); } while (0)
#define PG8_MMA(ai, bj, At, Bt) do { __builtin_amdgcn_s_setprio(1); _Pragma("unroll") for (int m = 0; m < 4; ++m) _Pragma("unroll") for (int n = 0; n < 2; ++n) _Pragma("unroll") for (int k = 0; k < 2; ++k) \
        acc[ai][bj][m][n] = __builtin_amdgcn_mfma_f32_16x16x32_bf16(Bt[n][k], At[m][k], acc[ai][bj][m][n], 0, 0, 0); __builtin_amdgcn_s_setprio(0); } while (0)
#define PG8_WAIT_V(n) asm volatile("s_waitcnt vmcnt(" #n ")" ::: "memory")
#define PG8_WAIT_L(n) asm volatile("s_waitcnt lgkmcnt(" #n ")" ::: "memory")
#define PG8_BAR __builtin_amdgcn_s_barrier()
#define PG8_SCHED __builtin_amdgcn_sched_barrier(0)
    Unit cur, nxt; int ui = 0;
    if (!S.next(0, cur)) return;
    f32x4 acc[2][2][4][2];
#pragma unroll
    for (int a = 0; a < 2; ++a)
#pragma unroll
        for (int b = 0; b < 2; ++b)
#pragma unroll
            for (int m = 0; m < 4; ++m)
#pragma unroll
                for (int n = 0; n < 2; ++n) acc[a][b][m][n] = (f32x4){0.f, 0.f, 0.f, 0.f};
    bf16x8 At[4][2], B0[2][2], B1[2][2];
#define PG8_UA(u_) (g.A + (size_t)(u_).pm * tstepA + (size_t)(HALFN ? (u_).sub % 3 : (u_).sub) * g.a_sub)
#define PG8_UB(u_) (g.Bt + (size_t)(u_).pn * tstepB + (HALFN ? (size_t)((u_).sub / 3) * hstepB : (size_t)0) + (size_t)(HALFN ? (u_).sub % 3 : (u_).sub) * g.b_sub)
    const char* cA = PG8_UA(cur); const char* cB = PG8_UB(cur);
    f32x4 msum[2][4][2];
    if constexpr (HALFN) {
#pragma unroll
        for (int a = 0; a < 2; ++a)
#pragma unroll
            for (int m = 0; m < 4; ++m)
#pragma unroll
                for (int n = 0; n < 2; ++n) msum[a][m][n] = (f32x4){0.f, 0.f, 0.f, 0.f};
    }
    PG8_STAGE(PG8_SB(0, 0), cB, voffB); PG8_STAGE(PG8_SB(0, 1), cB + hstepB, voffB); PG8_STAGE(PG8_SA(0, 0), cA, voffA); PG8_STAGE(PG8_SA(0, 1), cA + hstepA, voffA);
    if (wr == 1) PG8_BAR;
    PG8_WAIT_V(2); PG8_BAR;
    PG8_STAGE(PG8_SB(1, 0), cB + kstep, voffB); PG8_STAGE(PG8_SA(1, 0), cA + kstep, voffA); PG8_STAGE(PG8_SB(1, 1), cB + hstepB + kstep, voffB);
    PG8_WAIT_V(6); PG8_BAR;
    for (;;) {
        const bool has_next = S.next(ui + 1, nxt);
        const char* nA = has_next ? PG8_UA(nxt) : cA;
        const char* nB = has_next ? PG8_UB(nxt) : cB;
        for (int t = 0; t < nt; t += 2) {
            const bool last = (t == nt - 2);
            const char* a1 = cA + (size_t)(t + 1) * kstep;
            const char* a2 = last ? nA : cA + (size_t)(t + 2) * kstep; const char* b2 = last ? nB : cB + (size_t)(t + 2) * kstep;
            const char* a3 = a2 + kstep; const char* b3 = b2 + kstep;
            PG8_LDB(B0, 0, 0); if constexpr (!HALFN) PG8_LDB(B1, 0, 1); PG8_SCHED; PG8_LDA(At, 0, 0); PG8_STAGE(PG8_SA(1, 1), a1 + hstepA, voffA);
            PG8_WAIT_V(8); PG8_WAIT_L(0); PG8_BAR; PG8_MMA(0, 0, At, B0); if constexpr (!HALFN) PG8_MMA(0, 1, At, B1); PG8_BAR; PG8_SCHED;
            PG8_LDA(At, 0, 1); PG8_STAGE(PG8_SB(0, 0), b2, voffB); PG8_STAGE(PG8_SB(0, 1), b2 + hstepB, voffB); PG8_STAGE(PG8_SA(0, 0), a2, voffA);
            PG8_WAIT_V(8); PG8_WAIT_L(0); PG8_BAR; PG8_MMA(1, 0, At, B0); if constexpr (!HALFN) PG8_MMA(1, 1, At, B1); PG8_BAR; PG8_SCHED;
            PG8_LDB(B0, 1, 0); if constexpr (!HALFN) PG8_LDB(B1, 1, 1); PG8_SCHED; PG8_LDA(At, 1, 0); PG8_STAGE(PG8_SA(0, 1), a2 + hstepA, voffA);
            PG8_WAIT_V(8); PG8_WAIT_L(0); PG8_BAR; PG8_MMA(0, 0, At, B0); if constexpr (!HALFN) PG8_MMA(0, 1, At, B1); PG8_BAR; PG8_SCHED;
            PG8_LDA(At, 1, 1); PG8_STAGE(PG8_SB(1, 0), b3, voffB); PG8_STAGE(PG8_SB(1, 1), b3 + hstepB, voffB); PG8_STAGE(PG8_SA(1, 0), a3, voffA);
            PG8_WAIT_V(8); PG8_WAIT_L(0); PG8_BAR; PG8_MMA(1, 0, At, B0); if constexpr (!HALFN) PG8_MMA(1, 1, At, B1); PG8_BAR; PG8_SCHED;
        }
        if (wr == 0) PG8_BAR;
        if constexpr (HALFN) E(acc, msum, cur, wr, wc, fr, fq); else E(acc, cur, wr, wc, fr, fq);
        if (!has_next) break;
#pragma unroll
        for (int a = 0; a < 2; ++a)
#pragma unroll
            for (int b = 0; b < 2; ++b)
#pragma unroll
                for (int m = 0; m < 4; ++m)
#pragma unroll
                    for (int n = 0; n < 2; ++n) acc[a][b][m][n] = (f32x4){0.f, 0.f, 0.f, 0.f};
        cur = nxt; cA = nA; cB = nB; ++ui;
        if (wr == 1) PG8_BAR;
    }
    PG8_WAIT_V(0);
    PG8_BAR;
#undef PG8_UA
#undef PG8_UB
#undef PG8_SA
#undef PG8_SB
#undef PG8_STAGE
#undef PG8_LDA
#undef PG8_LDB
#undef PG8_MMA
#undef PG8_WAIT_V
#undef PG8_WAIT_L
#undef PG8_BAR
#undef PG8_SCHED
}
}
using pg8::Unit;

#define EPI_ARGS const f32x4 (&acc)[2][2][4][2], const Unit& u, int wr, int wc, int fr, int fq

constexpr int TBL_OFF = RING_BYTES + 64;
__device__ __forceinline__ const LAS float* fill_rstd_table(LAS unsigned char* lds, const float* ss, int pm, int wr, int wc, int fr, int fq) {
    LAS float* tbl = (LAS float*)(lds + TBL_OFF);
    const int t = (wr * 4 + wc) * 64 + fq * 16 + fr;
    if (t < 256) tbl[t] = row_rstd(ss, pm * 256 + t);
    asm volatile("s_waitcnt lgkmcnt(0)" ::: "memory"); __builtin_amdgcn_s_barrier(); asm volatile("" ::: "memory");
    return tbl;
}
struct EpiSwiglu {
    bf16_t* act; const float* ss; LAS unsigned char* lds;
    __device__ __forceinline__ void operator()(EPI_ARGS) const {
        const LAS float* tbl = fill_rstd_table(lds, ss, u.pm, wr, wc, fr, fq);
        const int row0 = u.pm * 256 + wr * 64 + fr, col0 = u.pn * 128 + wc * 32 + 8 * fq;
#pragma unroll
        for (int ai = 0; ai < 2; ++ai)
#pragma unroll
            for (int m = 0; m < 4; ++m) {
                const int row = row0 + ai * 128 + m * 16; const float rs = tbl[ai * 128 + wr * 64 + m * 16 + fr];
                f32x4 o[2];
#pragma unroll
                for (int n = 0; n < 2; ++n) { const f32x4 gt = acc[ai][0][m][n] * rs, up = acc[ai][1][m][n] * rs;
#pragma unroll
                    for (int j = 0; j < 4; ++j) o[n][j] = siluf_(gt[j]) * up[j]; }
                *(u32x4*)(act + (size_t)row * FF + col0) = pack8(o[0], o[1]);
            }
    }
};
struct EpiResid {
    const bf16_t* xin; bf16_t* xout; float* ss_out; float scale;
    __device__ __forceinline__ void operator()(EPI_ARGS) const {
        const int row0 = u.pm * 256 + wr * 64 + fr, col0 = u.pn * 256 + wc * 32 + 8 * fq;
        u32x4 xr[8][2];
#pragma unroll
        for (int g = 0; g < 8; ++g)
#pragma unroll
            for (int bj = 0; bj < 2; ++bj) xr[g][bj] = *(const u32x4*)(xin + (size_t)(row0 + (g >> 2) * 128 + (g & 3) * 16) * D + col0 + bj * 128);
        asm volatile("" ::: "memory");
#pragma unroll
        for (int ai = 0; ai < 2; ++ai)
#pragma unroll
            for (int m = 0; m < 4; ++m) {
                const int row = row0 + ai * 128 + m * 16; const size_t off = (size_t)row * D + col0; float sq = 0.f;
#pragma unroll
                for (int bj = 0; bj < 2; ++bj) {
                    const F8 xv = unpack8(xr[ai * 4 + m][bj]);
                    const f32x4 x0 = xv.a + acc[ai][bj][m][0] * scale, x1 = xv.b + acc[ai][bj][m][1] * scale;
                    *(u32x4*)(xout + off + bj * 128) = pack8(x0, x1);
                    sq += (x0[0] * x0[0] + x0[1] * x0[1]) + (x0[2] * x0[2] + x0[3] * x0[3]) + (x1[0] * x1[0] + x1[1] * x1[1]) + (x1[2] * x1[2] + x1[3] * x1[3]);
                }
                sq += __shfl_xor(sq, 16); sq += __shfl_xor(sq, 32);
                if (fq == 0) ss_out[(size_t)row * 16 + u.pn * 4 + wc] = sq;
            }
    }
};
struct EpiZin {
    bf16_t* z; const float* ss; LAS unsigned char* lds;
    __device__ __forceinline__ void operator()(EPI_ARGS) const {
        const LAS float* tbl = fill_rstd_table(lds, ss, u.pm, wr, wc, fr, fq);
        const int row0 = u.pm * 256 + wr * 64 + fr, col0 = u.pn * 256 + wc * 32 + 8 * fq;
        const int mode = u.pn < 4 ? 1 : (u.pn < 12 ? 0 : 2);
#pragma unroll
        for (int ai = 0; ai < 2; ++ai)
#pragma unroll
            for (int m = 0; m < 4; ++m) {
                const int row = row0 + ai * 128 + m * 16; const float rs = tbl[ai * 128 + wr * 64 + m * 16 + fr];
#pragma unroll
                for (int bj = 0; bj < 2; ++bj) {
                    f32x4 v0 = acc[ai][bj][m][0] * rs, v1 = acc[ai][bj][m][1] * rs;
                    if (mode == 1) {
#pragma unroll
                        for (int j = 0; j < 4; ++j) { v0[j] = gelu_tanh_(v0[j]); v1[j] = gelu_tanh_(v1[j]); }
                    } else if (mode == 2) {
#pragma unroll
                        for (int j = 0; j < 4; ++j) { v0[j] = sigmoidf_(v0[j]); v1[j] = sigmoidf_(v1[j]); }
                    }
                    *(u32x4*)(z + (size_t)row * DIN + col0 + bj * 128) = pack8(v0, v1);
                }
            }
    }
};
struct EpiMerge {
    unsigned char* zb;
    __device__ __forceinline__ void operator()(EPI_ARGS) const {
        const int row0 = u.pm * 256 + wr * 64 + fr, col0 = u.pn * 256 + wc * 32 + 8 * fq; const int sub = u.sub;
#pragma unroll
        for (int ai = 0; ai < 2; ++ai) {
            u32x4 gt[4][2], pr[4][2];
#pragma unroll
            for (int m = 0; m < 4; ++m) {
                unsigned char* rp = zb + (size_t)(row0 + ai * 128 + m * 16) * (DIN * 2);
#pragma unroll
                for (int bj = 0; bj < 2; ++bj) { const int col = col0 + bj * 128;
                    gt[m][bj] = *(const u32x4*)(rp + (size_t)(3072 + sub * 1024 + col) * 2);
                    if (sub > 0) pr[m][bj] = *(const u32x4*)(rp + (size_t)col * 2); }
            }
            asm volatile("" ::: "memory");
#pragma unroll
            for (int m = 0; m < 4; ++m) {
                unsigned char* rp = zb + (size_t)(row0 + ai * 128 + m * 16) * (DIN * 2);
#pragma unroll
                for (int bj = 0; bj < 2; ++bj) { const int col = col0 + bj * 128;
                    const F8 gv = unpack8(gt[m][bj]);
                    f32x4 v0 = acc[ai][bj][m][0] * gv.a, v1 = acc[ai][bj][m][1] * gv.b;
                    if (sub > 0) { const F8 pv = unpack8(pr[m][bj]); v0 += pv.a; v1 += pv.b; }
                    *(u32x4*)(rp + (size_t)col * 2) = pack8(v0, v1); }
            }
            asm volatile("" ::: "memory");
        }
    }
};
struct EpiMergeH {
    unsigned char* zb;
    __device__ __forceinline__ void operator()(const f32x4 (&acc)[2][2][4][2], f32x4 (&msum)[2][4][2], const Unit& u, int wr, int wc, int fr, int fq) const {
        const int b = u.sub % 3, h = u.sub / 3;
        const int row0 = u.pm * 256 + wr * 64 + fr, col = u.pn * 256 + h * 128 + wc * 32 + 8 * fq;
        u32x4 gt[2][4];
#pragma unroll
        for (int ai = 0; ai < 2; ++ai)
#pragma unroll
            for (int m = 0; m < 4; ++m) gt[ai][m] = *(const u32x4*)(zb + (size_t)(row0 + ai * 128 + m * 16) * (DIN * 2) + (size_t)(3072 + b * 1024 + col) * 2);
#pragma unroll
        for (int ai = 0; ai < 2; ++ai)
#pragma unroll
            for (int m = 0; m < 4; ++m) {
                const F8 gv = unpack8(gt[ai][m]);
                f32x4 v0 = acc[ai][0][m][0] * gv.a, v1 = acc[ai][0][m][1] * gv.b;
                if (b > 0) { v0 += msum[ai][m][0]; v1 += msum[ai][m][1]; }
                if (b < 2) { msum[ai][m][0] = v0; msum[ai][m][1] = v1; }
                else *(u32x4*)(zb + (size_t)(row0 + ai * 128 + m * 16) * (DIN * 2) + (size_t)col * 2) = pack8(v0, v1);
            }
    }
};
struct EpiPP {
    bf16_t* o;
    __device__ __forceinline__ void operator()(EPI_ARGS) const {
        const int row0 = u.pm * 256 + wr * 64 + fr, col0 = u.pn * 256 + wc * 32 + 8 * fq;
#pragma unroll
        for (int ai = 0; ai < 2; ++ai)
#pragma unroll
            for (int m = 0; m < 4; ++m) {
                const int row = row0 + ai * 128 + m * 16;
#pragma unroll
                for (int bj = 0; bj < 2; ++bj) *(u32x4*)(o + (size_t)row * D + col0 + bj * 128) = pack8(acc[ai][bj][m][0], acc[ai][bj][m][1]);
            }
    }
};
struct EpiPle {
    const bf16_t* xin; bf16_t* xout; const bf16_t* pp; const float* ss; float* ss_out; LAS unsigned char* lds;
    __device__ __forceinline__ void operator()(EPI_ARGS) const {
        const LAS float* tbl = fill_rstd_table(lds, ss, u.pm, wr, wc, fr, fq);
        const int row0 = u.pm * 256 + wr * 64 + fr, col0 = u.pn * 256 + wc * 32 + 8 * fq;
#pragma unroll
        for (int ai = 0; ai < 2; ++ai) {
            u32x4 pw[4][2], xw[4][2];
#pragma unroll
            for (int m = 0; m < 4; ++m) {
                const size_t off = (size_t)(row0 + ai * 128 + m * 16) * D + col0;
#pragma unroll
                for (int bj = 0; bj < 2; ++bj) { pw[m][bj] = *(const u32x4*)(pp + off + bj * 128); xw[m][bj] = *(const u32x4*)(xin + off + bj * 128); }
            }
            asm volatile("" ::: "memory");
#pragma unroll
            for (int m = 0; m < 4; ++m) {
                const int row = row0 + ai * 128 + m * 16; const size_t off = (size_t)row * D + col0; const float rs = tbl[ai * 128 + wr * 64 + m * 16 + fr]; float sq = 0.f;
#pragma unroll
                for (int bj = 0; bj < 2; ++bj) {
                    const F8 p = unpack8(pw[m][bj]); const F8 xr = unpack8(xw[m][bj]);
                    f32x4 x0 = xr.a, x1 = xr.b;
                    const f32x4 a0 = acc[ai][bj][m][0] * rs, a1 = acc[ai][bj][m][1] * rs;
#pragma unroll
                    for (int j = 0; j < 4; ++j) { x0[j] += sigmoidf_(a0[j]) * p.a[j]; x1[j] += sigmoidf_(a1[j]) * p.b[j]; }
                    *(u32x4*)(xout + off + bj * 128) = pack8(x0, x1);
                    sq += (x0[0] * x0[0] + x0[1] * x0[1]) + (x0[2] * x0[2] + x0[3] * x0[3]) + (x1[0] * x1[0] + x1[1] * x1[1]) + (x1[2] * x1[2] + x1[3] * x1[3]);
                }
                sq += __shfl_xor(sq, 16); sq += __shfl_xor(sq, 32);
                if (ss_out && fq == 0) ss_out[(size_t)row * 16 + u.pn * 4 + wc] = sq;
            }
            asm volatile("" ::: "memory");
        }
    }
};

__device__ __forceinline__ void convert_item(int MAP, const float* __restrict__ W, int N, const float* __restrict__ gsc, bf16_t* WT, int ldt, int row_off, int it, int lane) {
    const int nblk = N / 64;
    const int kb = it / nblk, nb = it - kb * nblk, n0 = 64 * nb, k0 = 64 * kb;
    int orow0;
    if (MAP == 0) orow0 = row_off + n0;
    else { const int h = n0 < FF ? n0 : n0 - FF; orow0 = (h >> 7) * 256 + (h & 127) + (n0 < FF ? 0 : 128); }
    const float* src = W + (size_t)k0 * N + n0 + lane;
    float v[64];
#pragma unroll
    for (int i = 0; i < 64; ++i) v[i] = src[(size_t)i * N];
    if (gsc) {
#pragma unroll
        for (int i = 0; i < 64; ++i) v[i] *= gsc[k0 + i];
    }
    bf16_t* dst = WT + (size_t)(orow0 + lane) * ldt + k0;
#pragma unroll
    for (int c = 0; c < 8; ++c) { u32x4 o; o.x = cvt_pk_bf16(v[8 * c], v[8 * c + 1]); o.y = cvt_pk_bf16(v[8 * c + 2], v[8 * c + 3]); o.z = cvt_pk_bf16(v[8 * c + 4], v[8 * c + 5]); o.w = cvt_pk_bf16(v[8 * c + 6], v[8 * c + 7]);
        *(u32x4*)(dst + 8 * c) = o; }
}
__device__ __forceinline__ void convert_job(int MAP, const float* __restrict__ W, int K, int N, const float* __restrict__ gsc, bf16_t* WT, int ldt, int row_off, int gw, int ngw, LAS float* scr, int lane) {
    const int items = (K / 64) * (N / 64);
    for (int it = gw; it < items; it += ngw) convert_item(MAP, W, N, gsc, WT, ldt, row_off, it, lane);
}
__device__ __forceinline__ int job_items(int id) {
    switch (id) {
    case 0: case 7: return (D / 64) * (2 * FF / 64);
    case 1: case 8: return (FF / 64) * (D / 64);
    case 2: return (D / 64) * (DIN / 64);
    case 3: case 4: return (512 / 64) * (D / 64);
    case 5: return 1024;
    case 6: case 10: return (D / 64) * (D / 64);
    case 9: return (DPLE / 64) * (D / 64);
    default: return M * DPLE / 8 / 256;
    }
}

#define XB_TMO      128
#define XB_XCNT(j)  (256  + 64 * (j))
#define XB_XSUB(j)  (1280 + 64 * (j))
#define XB_XGEN(j)  (2304 + 64 * (j))
#define XB_TOP      3328
#define XB_TOPGEN   3392
#define XCD_BAR_WORDS 3456
#define XB_SPIN_CAP (1u << 20)
__device__ __forceinline__ unsigned xb_ld(unsigned* p)              { return __hip_atomic_load(p, __ATOMIC_RELAXED, __HIP_MEMORY_SCOPE_AGENT); }
__device__ __forceinline__ unsigned xb_add(unsigned* p, unsigned v) { return __hip_atomic_fetch_add(p, v, __ATOMIC_RELAXED, __HIP_MEMORY_SCOPE_AGENT); }
__device__ __forceinline__ unsigned xb_xcc_id() { return (unsigned)__builtin_amdgcn_s_getreg((3 << 11) | 20) & 0xFu; }
#define XB_SPIN(cond, bar) do { unsigned _sp = 0; while (cond) { __builtin_amdgcn_s_sleep(1); \
    if ((++_sp & 255u) == 0u) { if (xb_ld(&(bar)[XB_TMO])) break; if (_sp > XB_SPIN_CAP) { atomicAdd(&(bar)[XB_TMO], 1u); break; } } } } while (0)
struct XcdBarrier { unsigned* bar; unsigned x; volatile LAS unsigned* st; };
__device__ __forceinline__ XcdBarrier xcd_barrier_post(unsigned* bar, volatile LAS unsigned* st) {
    XcdBarrier b; b.bar = bar; b.x = xb_xcc_id(); b.st = st;
    if (threadIdx.x == 0) (void)xb_add(&bar[XB_XCNT(b.x)], 1u);
    return b;
}
__device__ __forceinline__ void xcd_barrier_complete(unsigned* bar, unsigned x, unsigned& nloc, unsigned& nx) {
    const unsigned G = gridDim.x * gridDim.y * gridDim.z;
    unsigned sum, cnt, mine, sp = 0u;
    for (;;) {
        sum = 0u; cnt = 0u; mine = 0u;
#pragma unroll
        for (unsigned j = 0; j < 16; ++j) { const unsigned c = xb_ld(&bar[XB_XCNT(j)]); sum += c; cnt += (c > 0u) ? 1u : 0u; mine = (j == x) ? c : mine; }
        if (sum == G) break;
        __builtin_amdgcn_s_sleep(1);
        if ((++sp & 255u) == 0u) { if (xb_ld(&bar[XB_TMO])) break; if (sp > XB_SPIN_CAP) { atomicAdd(&bar[XB_TMO], 1u); break; } }
    }
    nloc = mine > 0u ? mine : 1u; nx = cnt > 0u ? cnt : 1u;
}
__device__ __forceinline__ void xcd_barrier(const XcdBarrier& b) {
    asm volatile("s_waitcnt vmcnt(0)" ::: "memory");
    __syncthreads();
    if (threadIdx.x == 0) {
        unsigned* bar = b.bar;
        __builtin_amdgcn_s_waitcnt(0);
        unsigned nloc = b.st[0], nx = b.st[1];
        if (nloc == 0u) { xcd_barrier_complete(bar, b.x, nloc, nx); b.st[0] = nloc; b.st[1] = nx; }
        const unsigned old = xb_add(&bar[XB_XSUB(b.x)], 1u);
        const unsigned gen = old / nloc;
        if (old + 1u == (gen + 1u) * nloc) {
            __builtin_amdgcn_fence(__ATOMIC_RELEASE, "agent");
            asm volatile("s_waitcnt vmcnt(0)" ::: "memory");
            const unsigned og = xb_add(&bar[XB_TOP], 1u);
            const unsigned tg = og / nx;
            if (og + 1u == (tg + 1u) * nx) xb_add(&bar[XB_TOPGEN], 1u);
            else XB_SPIN(xb_ld(&bar[XB_TOPGEN]) == tg, bar);
            __builtin_amdgcn_fence(__ATOMIC_ACQUIRE, "agent");
            xb_add(&bar[XB_XGEN(b.x)], 1u);
            asm volatile("s_waitcnt vmcnt(0)" ::: "memory");
        } else {
            XB_SPIN(xb_ld(&bar[XB_XGEN(b.x)]) == gen, bar);
            __builtin_amdgcn_fence(__ATOMIC_ACQUIRE, "agent");
            asm volatile("s_waitcnt vmcnt(0)" ::: "memory");
        }
    }
    __syncthreads();
}


__device__ __forceinline__ void skinny_phase(int kind, LAS unsigned char* lds, const char* gA, const char* gB, int lda, int ldb, int K, size_t asub, size_t bsub,
                                             void* e0, void* e1, const float* e2, float* e3, float scale, const bf16_t* ppb, const bf16_t* z, int G) {
    int tid = threadIdx.x; asm volatile("" : "+v"(tid));
    const int wave = __builtin_amdgcn_readfirstlane(tid >> 6), lane = tid & 63, fr = lane & 15, fq = lane >> 4;
    LAS float* red = (LAS float*)lds;
    const int ng = K >> 6, n = ng > wave ? (ng - wave + 7) >> 3 : 0, nb = kind == 4 ? 3 : 1;
    const int orow = tid >> 4, oc4 = (tid & 15) * 4;
    for (int piece = blockIdx.x; piece < 256; piece += G) {
        const int rg = piece >> 4, cg = piece & 15, row0 = MP + rg * 32, row = row0 + orow, col = cg * 64 + oc4;
        f32x4 msum = (f32x4){0.f, 0.f, 0.f, 0.f};
        unsigned long long xw_pre = 0ull, pw_pre = 0ull; float rs_pre = 0.f;
        if (kind == 1 || kind == 6) xw_pre = *(const unsigned long long*)((const bf16_t*)e0 + (size_t)row * D + col);
        if (kind == 6) { pw_pre = *(const unsigned long long*)(ppb + (size_t)row * D + col); rs_pre = row_rstd(e2, row); }
        for (int b = 0; b < nb; ++b) {
            unsigned long long gw_pre = 0ull;
            if (kind == 4) gw_pre = *(const unsigned long long*)(z + (size_t)row * DIN + 3072 + b * 1024 + col);
            const bf16_t* ap = (const bf16_t*)(gA + (size_t)b * asub) + (size_t)(row0 + fr) * lda + wave * 64 + fq * 8;
            const bf16_t* bp = (const bf16_t*)(gB + (size_t)b * bsub) + (size_t)(cg * 64 + fr) * ldb + wave * 64 + fq * 8;
            f32x4 acc[2][4];
#pragma unroll
            for (int rb = 0; rb < 2; ++rb)
#pragma unroll
                for (int cb = 0; cb < 4; ++cb) acc[rb][cb] = (f32x4){0.f, 0.f, 0.f, 0.f};
            bf16x8 av[2][2][2], bv[2][2][4];
#define SK_LD(buf, i) do { _Pragma("unroll") for (int h = 0; h < 2; ++h) { \
        _Pragma("unroll") for (int rb = 0; rb < 2; ++rb) av[buf][h][rb] = *(const bf16x8*)(ap + (size_t)(rb * 16) * lda + (i) * 512 + h * 32); \
        _Pragma("unroll") for (int cb = 0; cb < 4; ++cb) bv[buf][h][cb] = *(const bf16x8*)(bp + (size_t)(cb * 16) * ldb + (i) * 512 + h * 32); } } while (0)
#define SK_MM(buf) do { _Pragma("unroll") for (int h = 0; h < 2; ++h) _Pragma("unroll") for (int rb = 0; rb < 2; ++rb) _Pragma("unroll") for (int cb = 0; cb < 4; ++cb) \
        acc[rb][cb] = __builtin_amdgcn_mfma_f32_16x16x32_bf16(av[buf][h][rb], bv[buf][h][cb], acc[rb][cb], 0, 0, 0); } while (0)
            if (n > 0) SK_LD(0, 0);
            for (int i = 0; i < n; i += 2) {
                if (i + 1 < n) SK_LD(1, i + 1);
                SK_MM(0);
                if (i + 2 < n) SK_LD(0, i + 2);
                if (i + 1 < n) SK_MM(1);
            }
#undef SK_LD
#undef SK_MM
#pragma unroll
            for (int rb = 0; rb < 2; ++rb)
#pragma unroll
                for (int cb = 0; cb < 4; ++cb)
#pragma unroll
                    for (int j = 0; j < 4; ++j) red[(wave * 32 + rb * 16 + fq * 4 + j) * 64 + cb * 16 + fr] = acc[rb][cb][j];
            __syncthreads();
            f32x4 v = *(const LAS f32x4*)(red + orow * 64 + oc4);
#pragma unroll
            for (int w = 1; w < 8; ++w) v += *(const LAS f32x4*)(red + (w * 32 + orow) * 64 + oc4);
            if (kind == 4) {
                const unsigned long long gw_ = gw_pre;
                const unsigned lo = (unsigned)gw_, hi = (unsigned)(gw_ >> 32);
                msum += v * (f32x4){bf_lo(lo), bf_hi(lo), bf_lo(hi), bf_hi(hi)};
            } else msum = v;
            __syncthreads();
        }
        if (kind == 4) {
            *(unsigned long long*)((bf16_t*)e0 + (size_t)row * DIN + col) = (unsigned long long)cvt_pk_bf16(msum[0], msum[1]) | ((unsigned long long)cvt_pk_bf16(msum[2], msum[3]) << 32);
        } else if (kind == 5) {
            *(unsigned long long*)((bf16_t*)e0 + (size_t)row * D + col) = (unsigned long long)cvt_pk_bf16(msum[0], msum[1]) | ((unsigned long long)cvt_pk_bf16(msum[2], msum[3]) << 32);
        } else {
            const bf16_t* xi = (const bf16_t*)e0; bf16_t* xo = (bf16_t*)e1; const size_t off = (size_t)row * D + col;
            const unsigned long long xw = xw_pre; const unsigned lo = (unsigned)xw, hi = (unsigned)(xw >> 32);
            f32x4 x = (f32x4){bf_lo(lo), bf_hi(lo), bf_lo(hi), bf_hi(hi)};
            if (kind == 1) x += msum * scale;
            else {
                const float rs = rs_pre;
                const unsigned long long pw = pw_pre; const unsigned pl = (unsigned)pw, ph = (unsigned)(pw >> 32);
                const f32x4 p = (f32x4){bf_lo(pl), bf_hi(pl), bf_lo(ph), bf_hi(ph)};
#pragma unroll
                for (int j = 0; j < 4; ++j) x[j] += sigmoidf_(rs * msum[j]) * p[j];
            }
            *(unsigned long long*)(xo + off) = (unsigned long long)cvt_pk_bf16(x[0], x[1]) | ((unsigned long long)cvt_pk_bf16(x[2], x[3]) << 32);
            float sq = (x[0] * x[0] + x[1] * x[1]) + (x[2] * x[2] + x[3] * x[3]);
            sq += __shfl_xor(sq, 1); sq += __shfl_xor(sq, 2); sq += __shfl_xor(sq, 4); sq += __shfl_xor(sq, 8);
            if (e3 && (tid & 15) == 0) e3[(size_t)row * 16 + cg] = sq;
        }
    }
}

struct KArgs { const float* in[29]; float* out; unsigned char* ws; };
enum { I_XP = 0, I_XS, I_SCONV, I_SPOOL, I_PP, I_PS, I_GFFN1, I_WUP1, I_WDN1, I_GMIX, I_WIN, I_LNG, I_LNB, I_AWS, I_ABS, I_AOUT, I_BCONV, I_BOUT, I_CW, I_CSCALE, I_COUT, I_WO,
       I_GFFN2, I_WUP2, I_WDN2, I_GPLE, I_WPG, I_WPP, I_GFINAL };

__device__ __forceinline__ void mixer_a(const KArgs& a, int l, LAS unsigned char* lds, const bf16_t* z, bf16_t* mix, const bf16_t* wsb, int G) {
    int tid = threadIdx.x; asm volatile("" : "+v"(tid));
    const int wid = __builtin_amdgcn_readfirstlane(tid >> 6), lane = tid & 63, fr = lane & 15, fq = lane >> 4;
    LAS bf16_t* ldsV = (LAS bf16_t*)lds;
    LAS float* stats = (LAS float*)(lds + 40960);
    const float* lng = a.in[I_LNG] + l * 512; const float* lnb = a.in[I_LNB] + l * 512; const float* abs_ = a.in[I_ABS] + l * 512;
    {
        float* vout = a.out + O_VAS + (size_t)l * 128 * 4 * 512;
        const float* aws = a.in[I_AWS] + (size_t)l * 4 * 128 * 128;
        const int ch = lane * 8, g = lane >> 4;
        for (int sq = blockIdx.x * 8 + wid; sq < 128; sq += G * 8) {
            const int row0 = MP + sq * 4;
            u32x4 raw[4], uraw[4];
#pragma unroll
            for (int t = 0; t < 4; ++t) { raw[t] = *(const u32x4*)(z + (size_t)(row0 + t) * DIN + 512 + ch); uraw[t] = *(const u32x4*)(z + (size_t)(row0 + t) * DIN + ch); }
            const F8 gg = ld_f8(lng + ch), bb = ld_f8(lnb + ch);
            F8 vn[4];
#pragma unroll
            for (int t = 0; t < 4; ++t) {
                const F8 v = unpack8(raw[t]);
                float s = (v.a[0] + v.a[1]) + (v.a[2] + v.a[3]) + (v.b[0] + v.b[1]) + (v.b[2] + v.b[3]);
                float q = (v.a[0] * v.a[0] + v.a[1] * v.a[1]) + (v.a[2] * v.a[2] + v.a[3] * v.a[3]) + (v.b[0] * v.b[0] + v.b[1] * v.b[1]) + (v.b[2] * v.b[2] + v.b[3] * v.b[3]);
                s = wave_sum(s); q = wave_sum(q);
                const float mu = s * (1.0f / 512.0f), var = q * (1.0f / 512.0f) - mu * mu, rs = __builtin_amdgcn_rsqf(fmaxf(var, 0.f) + EPS);
                vn[t].a = (v.a - mu) * rs * gg.a + bb.a; vn[t].b = (v.b - mu) * rs * gg.b + bb.b;
                float* vo = vout + (size_t)(sq * 4 + t) * 512 + ch; *(f32x4*)vo = vn[t].a; *(f32x4*)(vo + 4) = vn[t].b;
            }
#pragma unroll
            for (int t = 0; t < 4; ++t) {
                const float bs = abs_[g * 128 + t];
                f32x4 m0 = (f32x4){bs, bs, bs, bs}, m1 = m0;
#pragma unroll
                for (int s_ = 0; s_ <= t; ++s_) { const float w = aws[(size_t)(g * 128 + t) * 128 + s_]; m0 += vn[s_].a * w; m1 += vn[s_].b * w; }
                const F8 uu = unpack8(uraw[t]);
                *(u32x4*)(mix + (size_t)(row0 + t) * NMIX + ch) = pack8(uu.a * m0, uu.b * m1);
            }
        }
    }
    for (int un = blockIdx.x; un < 512; un += G) {
        const int g = un & 3, cid = un >> 2, row0 = cid * 128;
        {
            u32x4 raw[16];
#pragma unroll
            for (int i = 0; i < 16; ++i) raw[i] = *(const u32x4*)(z + (size_t)(row0 + wid * 16 + i) * DIN + 512 + lane * 8);
#pragma unroll
            for (int i = 0; i < 16; ++i) {
                const int r = wid * 16 + i; const F8 v = unpack8(raw[i]);
                float s = (v.a[0] + v.a[1]) + (v.a[2] + v.a[3]) + (v.b[0] + v.b[1]) + (v.b[2] + v.b[3]);
                float q = (v.a[0] * v.a[0] + v.a[1] * v.a[1]) + (v.a[2] * v.a[2] + v.a[3] * v.a[3]) + (v.b[0] * v.b[0] + v.b[1] * v.b[1]) + (v.b[2] * v.b[2] + v.b[3] * v.b[3]);
                s = wave_sum(s); q = wave_sum(q);
                const float mu = s * (1.0f / 512.0f), var = q * (1.0f / 512.0f) - mu * mu;
                if (lane == 0) { stats[2 * r] = mu; stats[2 * r + 1] = __builtin_amdgcn_rsqf(fmaxf(var, 0.f) + EPS); }
            }
        }
        __syncthreads();
#pragma unroll
        for (int it = 0; it < 4; ++it) {
            const int item = it * NT + tid, r = item >> 4, seg = item & 15, ch = g * 128 + seg * 8;
            const F8 v = ld_bf8(z + (size_t)(row0 + r) * DIN + 512 + ch);
            const float mu = stats[2 * r], rs = stats[2 * r + 1];
            const F8 gg = ld_f8(lng + ch), bb = ld_f8(lnb + ch);
            const u32x4 w = pack8((v.a - mu) * rs * gg.a + bb.a, (v.b - mu) * rs * gg.b + bb.b);
            LAS bf16_t* dst = ldsV + (seg * 8) * 136 + r;
            dst[0 * 136] = (bf16_t)(w.x & 0xffffu); dst[1 * 136] = (bf16_t)(w.x >> 16); dst[2 * 136] = (bf16_t)(w.y & 0xffffu); dst[3 * 136] = (bf16_t)(w.y >> 16);
            dst[4 * 136] = (bf16_t)(w.z & 0xffffu); dst[5 * 136] = (bf16_t)(w.z >> 16); dst[6 * 136] = (bf16_t)(w.w & 0xffffu); dst[7 * 136] = (bf16_t)(w.w >> 16);
        }
        const int t0 = wid * 16, ksteps = (t0 + 16 + 31) >> 5;
        bf16x8 wv[4];
        const bf16_t* wrow = wsb + ((size_t)(l * 4 + g) * 128 + t0 + fr) * 128 + fq * 8;
#pragma unroll
        for (int k = 0; k < 4; ++k) wv[k] = *(const bf16x8*)(wrow + (k < ksteps ? k : 0) * 32);
        const int trow = row0 + t0 + fr;
        unsigned long long uw[8];
#pragma unroll
        for (int cb = 0; cb < 8; ++cb) uw[cb] = *(const unsigned long long*)(z + (size_t)trow * DIN + g * 128 + cb * 16 + fq * 4);
        const float bs = abs_[g * 128 + t0 + fr];
        __syncthreads();
        f32x4 acc[8];
#pragma unroll
        for (int cb = 0; cb < 8; ++cb) acc[cb] = (f32x4){0.f, 0.f, 0.f, 0.f};
#pragma unroll
        for (int k = 0; k < 4; ++k) {
            if (k < ksteps) {
#pragma unroll
                for (int cb = 0; cb < 8; ++cb) {
                    const bf16x8 vv = *(const LAS bf16x8*)(ldsV + (cb * 16 + fr) * 136 + k * 32 + fq * 8);
                    acc[cb] = __builtin_amdgcn_mfma_f32_16x16x32_bf16(vv, wv[k], acc[cb], 0, 0, 0);
                }
            }
        }
#pragma unroll
        for (int cb = 0; cb < 8; ++cb) {
            const unsigned lo = (unsigned)uw[cb], hi = (unsigned)(uw[cb] >> 32);
            const unsigned o0 = cvt_pk_bf16(bf_lo(lo) * (acc[cb][0] + bs), bf_hi(lo) * (acc[cb][1] + bs)), o1 = cvt_pk_bf16(bf_lo(hi) * (acc[cb][2] + bs), bf_hi(hi) * (acc[cb][3] + bs));
            *(unsigned long long*)(mix + (size_t)trow * NMIX + g * 128 + cb * 16 + fq * 4) = (unsigned long long)o0 | ((unsigned long long)o1 << 32);
        }
        __syncthreads();
    }
}

__device__ __forceinline__ void mixer_bc(const KArgs& a, int l, const bf16_t* z, bf16_t* mix, int G) {
    const float* sconv = a.in[I_SCONV] + (size_t)l * 128 * 2 * 512;
    const float* spool = a.in[I_SPOOL] + (size_t)l * 128 * 15 * 512;
    const float* bconv = a.in[I_BCONV] + l * 3 * 512;
    float* oconvp = a.out + O_CONVP + (size_t)l * 8 * 2 * 512;
    float* oconvs = a.out + O_CONVS + (size_t)l * 128 * 2 * 512;
    float* opoolp = a.out + O_POOLP + (size_t)l * 8 * 15 * 512;
    float* opools = a.out + O_POOLS + (size_t)l * 128 * 15 * 512;
    int tid = threadIdx.x; asm volatile("" : "+v"(tid));
    for (int idx = blockIdx.x * NT + tid; idx < (MP / 2) * 64; idx += G * NT) {
        const int m = (idx >> 6) * 2, seg = idx & 63, ch = seg * 8;
        const bf16_t* zr = z + (size_t)m * DIN;
        const int gi = seg >> 4, win = 2 << gi;
        const F8 w0 = ld_f8(bconv + ch), w1 = ld_f8(bconv + 512 + ch), w2 = ld_f8(bconv + 1024 + ch);
        const int sq = m >> 11, t0 = m & 2047;
        const float k2 = t0 >= 2 ? 1.f : 0.f;
        const bf16_t* zm1 = t0 >= 2 ? zr - DIN : zr; const bf16_t* zm2 = t0 >= 2 ? zr - 2 * DIN : zr;
        const F8 gA_ = ld_bf8(zm2 + 1536 + ch), xA_ = ld_bf8(zm2 + 2048 + ch), gB_ = ld_bf8(zm1 + 1536 + ch), xB_ = ld_bf8(zm1 + 2048 + ch);
        const F8 gC_ = ld_bf8(zr + 1536 + ch), xC_ = ld_bf8(zr + 2048 + ch), gD_ = ld_bf8(zr + DIN + 1536 + ch), xD_ = ld_bf8(zr + DIN + 2048 + ch);
        const F8 bg0 = ld_bf8(zr + 1024 + ch), bg1 = ld_bf8(zr + DIN + 1024 + ch);
        F8 r[17];
#pragma unroll
        for (int k = 0; k < 17; ++k) { const bool ok = (k <= win) && (k <= t0 + 1); r[k] = ld_bf8((ok ? zr + DIN - (size_t)k * DIN : zr) + 2560 + ch); }
        const f32x4 cAa = gA_.a * xA_.a * k2, cAb = gA_.b * xA_.b * k2, cBa = gB_.a * xB_.a * k2, cBb = gB_.b * xB_.b * k2;
        const f32x4 cCa = gC_.a * xC_.a, cCb = gC_.b * xC_.b, cDa = gD_.a * xD_.a, cDb = gD_.b * xD_.b;
        *(u32x4*)(mix + (size_t)m * NMIX + 512 + ch) = pack8(bg0.a * (cAa * w0.a + cBa * w1.a + cCa * w2.a), bg0.b * (cAb * w0.b + cBb * w1.b + cCb * w2.b));
        *(u32x4*)(mix + (size_t)(m + 1) * NMIX + 512 + ch) = pack8(bg1.a * (cBa * w0.a + cCa * w1.a + cDa * w2.a), bg1.b * (cBb * w0.b + cCb * w1.b + cDb * w2.b));
        if (t0 == 2046) { float* o = oconvp + (size_t)(sq * 2) * 512 + ch; *(f32x4*)o = cCa; *(f32x4*)(o + 4) = cCb; *(f32x4*)(o + 512) = cDa; *(f32x4*)(o + 516) = cDb; }
        f32x4 s1a = r[0].a, s1b = r[0].b, s0a = r[1].a, s0b = r[1].b;
#pragma unroll
        for (int k = 1; k < 17; ++k) {
            const float wt1 = (k < win && k <= t0 + 1) ? 1.f : 0.f, wt0 = (k >= 2 && k <= win && k - 1 <= t0) ? 1.f : 0.f;
            s1a += r[k].a * wt1; s1b += r[k].b * wt1; s0a += r[k].a * wt0; s0b += r[k].b * wt0;
        }
        const float inv0 = 1.0f / (float)(win < t0 + 1 ? win : t0 + 1), inv1 = 1.0f / (float)(win < t0 + 2 ? win : t0 + 2);
        *(u32x4*)(mix + (size_t)m * NMIX + 1024 + ch) = pack8(s0a * inv0 - r[1].a, s0b * inv0 - r[1].b);
        *(u32x4*)(mix + (size_t)(m + 1) * NMIX + 1024 + ch) = pack8(s1a * inv1 - r[0].a, s1b * inv1 - r[0].b);
        if (t0 + 1 >= 2033) {
            if (t0 >= 2033) { float* o = opoolp + (size_t)(sq * 15 + (t0 - 2033)) * 512 + ch; *(f32x4*)o = r[1].a; *(f32x4*)(o + 4) = r[1].b; }
            float* o = opoolp + (size_t)(sq * 15 + (t0 + 1 - 2033)) * 512 + ch; *(f32x4*)o = r[0].a; *(f32x4*)(o + 4) = r[0].b;
        }
    }
    for (int idx = blockIdx.x * NT + tid; idx < MS * 64; idx += G * NT) {
        const int m = MP + (idx >> 6), seg = idx & 63, ch = seg * 8;
        const bf16_t* zr = z + (size_t)m * DIN;
        const int gi = seg >> 4, win = 2 << gi;
        const F8 w0 = ld_f8(bconv + ch), w1 = ld_f8(bconv + 512 + ch), w2 = ld_f8(bconv + 1024 + ch);
        {
            const int sq = (m - MP) >> 2, t = (m - MP) & 3;
            F8 c2, c1, c0;
            { const F8 cg_ = ld_bf8(zr + 1536 + ch), xb_ = ld_bf8(zr + 2048 + ch); c2.a = cg_.a * xb_.a; c2.b = cg_.b * xb_.b; }
            if (t >= 1) { const F8 cg_ = ld_bf8(zr - DIN + 1536 + ch), xb_ = ld_bf8(zr - DIN + 2048 + ch); c1.a = cg_.a * xb_.a; c1.b = cg_.b * xb_.b; }
            else c1 = ld_f8(sconv + (size_t)(sq * 2 + 1) * 512 + ch);
            if (t >= 2) { const F8 cg_ = ld_bf8(zr - 2 * DIN + 1536 + ch), xb_ = ld_bf8(zr - 2 * DIN + 2048 + ch); c0.a = cg_.a * xb_.a; c0.b = cg_.b * xb_.b; }
            else c0 = ld_f8(sconv + (size_t)(sq * 2 + t) * 512 + ch);
            {
                const F8 bg = ld_bf8(zr + 1024 + ch);
                const f32x4 ya = bg.a * (c0.a * w0.a + c1.a * w1.a + c2.a * w2.a), yb = bg.b * (c0.b * w0.b + c1.b * w1.b + c2.b * w2.b);
                *(u32x4*)(mix + (size_t)m * NMIX + 512 + ch) = pack8(ya, yb);
            }
            if (t >= 2) { float* o = oconvs + (size_t)(sq * 2 + (t - 2)) * 512 + ch; *(f32x4*)o = c2.a; *(f32x4*)(o + 4) = c2.b; }
            const F8 xt = ld_bf8(zr + 2560 + ch);
            f32x4 s0 = xt.a, s1 = xt.b;
            for (int i = 1; i < win; ++i) {
                const int tp = t - i;
                if (tp >= 0) { const F8 v = ld_bf8(zr - (size_t)i * DIN + 2560 + ch); s0 += v.a; s1 += v.b; }
                else { const F8 v = ld_f8(spool + (size_t)(sq * 15 + 15 + tp) * 512 + ch); s0 += v.a; s1 += v.b; }
            }
            const float inv = 1.0f / (float)win;
            *(u32x4*)(mix + (size_t)m * NMIX + 1024 + ch) = pack8(s0 * inv - xt.a, s1 * inv - xt.b);
            float* o = opools + (size_t)(sq * 15 + 11 + t) * 512 + ch; *(f32x4*)o = xt.a; *(f32x4*)(o + 4) = xt.b;
            if (t == 0) {
                for (int j = 0; j < 11; ++j) { const F8 v = ld_f8(spool + (size_t)(sq * 15 + j + 4) * 512 + ch); float* oj = opools + (size_t)(sq * 15 + j) * 512 + ch; *(f32x4*)oj = v.a; *(f32x4*)(oj + 4) = v.b; }
            }
        }
    }
}

__global__ void __launch_bounds__(NT, 2) fwd_kernel(KArgs a) {
    extern __shared__ __attribute__((aligned(16))) unsigned char lds_raw[];
    LAS unsigned char* lds = (LAS unsigned char*)lds_raw;
    cg::grid_group grid = cg::this_grid();
    const int G = gridDim.x, bx = blockIdx.x;
    const int ngw = G * 8, ngt = G * NT;
    unsigned char* ws = a.ws;
    float* xf = a.out;
    float* ssb = (float*)(ws + WS_SS);
    bf16_t* wsb = (bf16_t*)(ws + WS_WSB);
    unsigned char* wa = (unsigned char*)a.out;
    bf16_t* xb = (bf16_t*)(ws + WS_XB);
    bf16_t* mix = (bf16_t*)(ws + WS_MIX);
    bf16_t* pb = (bf16_t*)(ws + WS_MIX);
    bf16_t* xbn = (bf16_t*)(ws + WS_MIX + XBN_OFF);
    bf16_t* big = (bf16_t*)(ws + WS_BIG);
    bf16_t* ppb = (bf16_t*)(ws + WS_BIG + PP_OFF);
#define SSB(l, i) (ssb + (size_t)((l) * 4 + (i)) * (M * 16))

    if (PHASE_MASK & 1) {
    int tid_o = threadIdx.x; asm volatile("" : "+v"(tid_o));
    const int lane = tid_o & 63, wave = __builtin_amdgcn_readfirstlane(tid_o >> 6);
    const int gw = bx * 8 + wave, gt = bx * NT + tid_o;
    LAS float* scr = (LAS float*)(lds + wave * 16384);
    for (int m0 = gw; m0 < M; m0 += 3 * ngw) {
        f32x4 v[3][4]; float s[3];
#pragma unroll
        for (int r = 0; r < 3; ++r) {
            const int m = (m0 + r * ngw) < M ? m0 + r * ngw : m0;
            const float* src = m < MP ? a.in[I_XP] + (size_t)m * D : a.in[I_XS] + (size_t)(m - MP) * D;
#pragma unroll
            for (int j = 0; j < 4; ++j) v[r][j] = *(const f32x4*)(src + j * 256 + lane * 4);
        }
#pragma unroll
        for (int r = 0; r < 3; ++r) {
            float t = 0.f;
#pragma unroll
            for (int j = 0; j < 4; ++j) t += (v[r][j][0] * v[r][j][0] + v[r][j][1] * v[r][j][1]) + (v[r][j][2] * v[r][j][2] + v[r][j][3] * v[r][j][3]);
            s[r] = wave_sum(t);
        }
#pragma unroll
        for (int r = 0; r < 3; ++r) {
            const int m = m0 + r * ngw;
            if (m < M) {
#pragma unroll
                for (int j = 0; j < 4; ++j)
                    *(unsigned long long*)(xb + (size_t)m * D + j * 256 + lane * 4) = (unsigned long long)cvt_pk_bf16(v[r][j][0], v[r][j][1]) | ((unsigned long long)cvt_pk_bf16(v[r][j][2], v[r][j][3]) << 32);
                if (lane < 16) SSB(0, 0)[(size_t)m * 16 + lane] = lane == 0 ? s[r] : 0.f;
            }
        }
    }
    for (int i = gt; i < 2 * 4 * 128 * 128; i += ngt) { const int tt = (i >> 7) & 127, s_ = i & 127; const float v = a.in[I_AWS][i]; wsb[i] = (bf16_t)(cvt_pk_bf16(s_ <= tt ? v : 0.f, 0.f) & 0xffffu); }
    convert_job(1, a.in[I_WUP1], D, 2 * FF, a.in[I_GFFN1], (bf16_t*)(wa + WA_UP1), D, 0, gw, ngw, scr, lane);
    }
    volatile LAS unsigned* bst = (volatile LAS unsigned*)(lds + RING_BYTES);
    if (threadIdx.x == 0) { bst[0] = 0u; bst[1] = 0u; }
    const XcdBarrier xbar = xcd_barrier_post((unsigned*)(ws + WS_BAR), bst);
    if (ws == nullptr) grid.sync();

#pragma unroll 1
    for (int st = 0; st <= 20; ++st) {
        const int l = st >= 10 ? 1 : 0, s = st - 10 * l;
        if (s != 8) { xcd_barrier(xbar); if (PROBE == 4) xcd_barrier(xbar); }
        int tid_o = threadIdx.x; asm volatile("" : "+v"(tid_o));
        const int lane = tid_o & 63, wave = __builtin_amdgcn_readfirstlane(tid_o >> 6);
        if (s == 10) {
            if ((PHASE_MASK >> 11) & 1) {
            const int gw = bx * 8 + wave;
            const float* gf = a.in[I_GFINAL];
            for (int m0 = gw; m0 < M; m0 += 3 * ngw) {
                unsigned long long w[3][4]; f32x4 gg[4];
#pragma unroll
                for (int r = 0; r < 3; ++r) { const int m = (m0 + r * ngw) < M ? m0 + r * ngw : m0;
#pragma unroll
                    for (int j = 0; j < 4; ++j) w[r][j] = *(const unsigned long long*)(xbn + (size_t)m * D + j * 256 + lane * 4); }
#pragma unroll
                for (int j = 0; j < 4; ++j) gg[j] = *(const f32x4*)(gf + j * 256 + lane * 4);
#pragma unroll
                for (int r = 0; r < 3; ++r) {
                    const int m = m0 + r * ngw;
                    f32x4 v[4]; float sm = 0.f;
#pragma unroll
                    for (int j = 0; j < 4; ++j) { const unsigned lo = (unsigned)w[r][j], hi = (unsigned)(w[r][j] >> 32);
                        v[j] = (f32x4){bf_lo(lo), bf_hi(lo), bf_lo(hi), bf_hi(hi)}; sm += (v[j][0] * v[j][0] + v[j][1] * v[j][1]) + (v[j][2] * v[j][2] + v[j][3] * v[j][3]); }
                    sm = wave_sum(sm);
                    const float rs = 1.0f / sqrtf(sm * (1.0f / 1024.0f) + EPS);
                    if (m < M) {
#pragma unroll
                        for (int j = 0; j < 4; ++j) *(f32x4*)(xf + (size_t)m * D + j * 256 + lane * 4) = v[j] * rs * gg[j];
                    }
                }
            }
            }
            continue;
        }
        int kind = -1, sync = 1, nj = 0;
        const char* gA = nullptr; const char* gB = nullptr; int lda = 0, ldb = 0, gK = 0, gN = 0, nsub = 1; size_t asub = 0, bsub = 0;
        void* e0 = nullptr; void* e1 = nullptr; const float* e2 = nullptr; float* e3 = nullptr; float scale = 0.f;
        switch (s) {
        case 0: nj = l == 0 ? 2 : 1;
                kind = 0; gA = (const char*)(l == 0 ? xb : xbn); gB = (const char*)(wa + WA_UP1); lda = D; ldb = D; gK = D; gN = 2 * FF; e0 = big; e2 = SSB(l, 0); break;
        case 1: kind = 1; gA = (const char*)big; gB = (const char*)(wa + WA_DN1); lda = FF; ldb = FF; gK = FF; gN = D; e0 = (void*)(l == 0 ? xb : xbn); e1 = xb; e3 = SSB(l, 1); scale = 0.5f; break;
        case 2: nj = l == 0 ? 10 : 8;
                kind = 2; gA = (const char*)xb; gB = (const char*)(wa + WA_IN); lda = D; ldb = D; gK = D; gN = DIN; e0 = big; e2 = SSB(l, 1); break;
        case 3: kind = 3; break;
        case 4: kind = 4; gA = (const char*)mix; gB = (const char*)(wa + WA_ABC); lda = NMIX; ldb = 512; gK = 512; gN = D; nsub = 6; asub = 512 * 2; bsub = (size_t)1024 * 512 * 2; e0 = big; break;
        case 5: kind = 1; gA = (const char*)big; gB = (const char*)(wa + WA_O); lda = DIN; ldb = D; gK = D; gN = D; e0 = xb; e1 = xb; e3 = SSB(l, 2); scale = 1.0f; break;
        case 6: nj = 1;
                kind = 0; gA = (const char*)xb; gB = (const char*)(wa + WA_UP2); lda = D; ldb = D; gK = D; gN = 2 * FF; e0 = big; e2 = SSB(l, 2); break;
        case 7: kind = 1; sync = 0; gA = (const char*)big; gB = (const char*)(wa + WA_DN2); lda = FF; ldb = FF; gK = FF; gN = D; e0 = xb; e1 = xb; e3 = SSB(l, 3); scale = 0.5f; break;
        case 8: kind = 5; gA = (const char*)pb; gB = (const char*)(wa + WA_PROJ); lda = DPLE; ldb = DPLE; gK = DPLE; gN = D; e0 = ppb; break;
        default: kind = 6; gA = (const char*)xb; gB = (const char*)(wa + WA_PG); lda = D; ldb = D; gK = D; gN = D; e0 = xb; e1 = xbn; e2 = SSB(l, 3); e3 = l == 0 ? SSB(1, 0) : nullptr; break;
        }
        if ((PHASE_MASK >> (s + 1)) & 1) {
        if (nj > 0) {
            const int nwg = (M / 256) * (gN / 256), rem = nwg % G;
            if (bx >= rem) {
                const int gw = (bx - rem) * 8 + wave, ngw_l = (G - rem) * 8;
                int total = 0;
                for (int ji = 0; ji < nj; ++ji) { const int id = s == 0 ? (l == 0 ? 1 + ji : 2) : (s == 2 ? (ji < 8 ? 3 + ji : ji - 8) : 11); total += job_items(id); }
                for (int rp = 0; rp < (PROBE == 3 ? 2 : 1); ++rp)
                for (int it = gw; it < total; it += ngw_l) {
                    int r = it, id = 0, jl = l;
                    for (int ji = 0; ji < nj; ++ji) { id = s == 0 ? (l == 0 ? 1 + ji : 2) : (s == 2 ? (ji < 8 ? 3 + ji : ji - 8) : 11); jl = (s == 2 && ji >= 8) ? 1 : l; const int c = job_items(id); if (r < c) break; r -= c; }
                    if (id == 5) {
                        const float* cw = a.in[I_CW] + (size_t)jl * 4 * 128 * 128; const float* cs = a.in[I_CSCALE] + jl * 512; const float* co = a.in[I_COUT] + (size_t)jl * 512 * D;
                        bf16_t* wdst = (bf16_t*)(wa + WA_ABC);
                        const int i = r * 64 + lane;
                        const int k0 = (i >> 10) * 8, n = i & 1023, gq = k0 >> 7;
                        const float* cwr = cw + (size_t)k0 * 128; const float* csr = cs + gq * 128; const float* cor = co + (size_t)(gq * 128) * D + n;
                        float sm[8];
#pragma unroll
                        for (int j = 0; j < 8; ++j) sm[j] = 0.f;
#pragma unroll 8
                        for (int d = 0; d < 128; ++d) { const float v = csr[d] * cor[(size_t)d * D];
#pragma unroll
                            for (int j = 0; j < 8; ++j) sm[j] += cwr[j * 128 + d] * v; }
                        u32x4 o; o.x = cvt_pk_bf16(sm[0], sm[1]); o.y = cvt_pk_bf16(sm[2], sm[3]); o.z = cvt_pk_bf16(sm[4], sm[5]); o.w = cvt_pk_bf16(sm[6], sm[7]);
                        *(u32x4*)(wdst + (size_t)(2048 + n) * 512 + k0) = o;
                    } else if (id == 11) {
                        const float* ppr = a.in[I_PP] + (size_t)jl * MP * DPLE; const float* psm = a.in[I_PS] + (size_t)jl * MS * DPLE;
#pragma unroll
                        for (int q = 0; q < 4; ++q) {
                            const size_t e = ((size_t)r * 256 + q * 64 + lane) * 8; const float* src = e < (size_t)MP * DPLE ? ppr + e : psm + (e - (size_t)MP * DPLE);
                            const F8 v = ld_f8(src); *(u32x4*)(pb + e) = pack8(v.a, v.b);
                        }
                    } else {
                        const float* jW; const float* jG = nullptr; unsigned char* jD; int jK, jN, jL, jR = 0, jM = 0;
                        switch (id) {
                        case 0: jW = a.in[I_WUP1] + (size_t)jl * D * 2 * FF; jG = a.in[I_GFFN1] + jl * D; jD = wa + WA_UP1; jK = D; jN = 2 * FF; jL = D; jM = 1; break;
                        case 1: jW = a.in[I_WDN1] + (size_t)jl * FF * D; jD = wa + WA_DN1; jK = FF; jN = D; jL = FF; break;
                        case 2: jW = a.in[I_WIN] + (size_t)jl * D * DIN; jG = a.in[I_GMIX] + jl * D; jD = wa + WA_IN; jK = D; jN = DIN; jL = D; break;
                        case 3: jW = a.in[I_AOUT] + (size_t)jl * 512 * D; jD = wa + WA_ABC; jK = 512; jN = D; jL = 512; break;
                        case 4: jW = a.in[I_BOUT] + (size_t)jl * 512 * D; jD = wa + WA_ABC; jK = 512; jN = D; jL = 512; jR = 1024; break;
                        case 6: jW = a.in[I_WO] + (size_t)jl * D * D; jD = wa + WA_O; jK = D; jN = D; jL = D; break;
                        case 7: jW = a.in[I_WUP2] + (size_t)jl * D * 2 * FF; jG = a.in[I_GFFN2] + jl * D; jD = wa + WA_UP2; jK = D; jN = 2 * FF; jL = D; jM = 1; break;
                        case 8: jW = a.in[I_WDN2] + (size_t)jl * FF * D; jD = wa + WA_DN2; jK = FF; jN = D; jL = FF; break;
                        case 9: jW = a.in[I_WPP] + (size_t)jl * DPLE * D; jD = wa + WA_PROJ; jK = DPLE; jN = D; jL = DPLE; break;
                        default: jW = a.in[I_WPG] + (size_t)jl * D * D; jG = a.in[I_GPLE] + jl * D; jD = wa + WA_PG; jK = D; jN = D; jL = D; break;
                        }
                        convert_item(jM, jW, jN, jG, (bf16_t*)jD, jL, jR, r, lane);
                    }
                }
            }
        }
        for (int rb = 0; rb < (((PROBE == 1 && s == 0) || (PROBE == 2 && s == 3) || (PROBE == 5 && (s == 1 || s == 7)) || (PROBE == 6 && s == 4) || (PROBE == 7 && s == 5) || (PROBE == 11 && s == 7)) ? 2 : 1); ++rb) {
        if (PROBE >= 5 && rb == 1) scale = 0.f;
        if (kind == 3) {
            for (int q = 0; q < (PROBE == 8 ? 2 : 1); ++q) mixer_a(a, l, lds, big, mix, wsb, G);
            for (int q = 0; q < (PROBE == 9 ? 2 : 1); ++q) mixer_bc(a, l, big, mix, G);
        } else {
            const bool narrow = (kind == 1 || kind >= 4);
            pg8::Gemm g{gA, gB, lda, ldb, gK, asub, bsub}; pg8::StaticOrder S; S.init(narrow ? MP : M, gN, G, bx, nsub);
            switch (kind) {
            case 0: { EpiSwiglu E{(bf16_t*)e0, e2, lds}; pg8::gemm_phase(lds, g, S, E); } break;
            case 1: { EpiResid E{(const bf16_t*)e0, (bf16_t*)e1, e3, scale}; pg8::gemm_phase(lds, g, S, E); } break;
            case 2: { EpiZin E{(bf16_t*)e0, e2, lds}; pg8::gemm_phase(lds, g, S, E); } break;
            case 4: { EpiMergeH E{(unsigned char*)e0}; pg8::gemm_phase<EpiMergeH, true>(lds, g, S, E); } break;
            case 5: { EpiPP E{(bf16_t*)e0}; pg8::gemm_phase(lds, g, S, E); } break;
            default: { EpiPle E{(const bf16_t*)e0, (bf16_t*)e1, ppb, e2, e3, lds}; pg8::gemm_phase(lds, g, S, E); } break;
            }
            if (narrow) for (int q = 0; q < (((PROBE == 10 && kind != 6) || (PROBE == 12 && s == 7)) ? 2 : 1); ++q) skinny_phase(kind, lds, gA, gB, lda, ldb, gK, asub, bsub, e0, e1, e2, e3, q ? 0.f : scale, ppb, big, G);
        }
        }
        }
    }

}

extern "C" void kernel_launch(void* const* d_in, const int* in_sizes, int n_in, void* d_out, int out_size, void* d_ws, size_t ws_size, hipStream_t stream) {
    static int grid = 0;
    if (grid == 0) {
        if (n_in != 29 || ws_size < WS_END) { fprintf(stderr, "kernel_launch: need 29 inputs and >= %zu bytes of workspace; got %d, %zu\n", (size_t)WS_END, n_in, ws_size); grid = -1; return; }
        int dev = 0, cus = 0, per_cu = 0;
        if (hipGetDevice(&dev) != hipSuccess || hipDeviceGetAttribute(&cus, hipDeviceAttributeMultiprocessorCount, dev) != hipSuccess) { grid = -1; return; }
        if (hipFuncSetAttribute((const void*)fwd_kernel, hipFuncAttributeMaxDynamicSharedMemorySize, LDS_BYTES) != hipSuccess) { fprintf(stderr, "kernel_launch: hipFuncSetAttribute failed\n"); grid = -1; return; }
        if (hipOccupancyMaxActiveBlocksPerMultiprocessor(&per_cu, (const void*)fwd_kernel, NT, LDS_BYTES) != hipSuccess || per_cu < 1) { fprintf(stderr, "kernel_launch: occupancy query says %d\n", per_cu); grid = -1; return; }
        grid = cus * per_cu;
    }
    if (grid < 0) return;
    if (hipMemsetAsync((char*)d_ws + WS_BAR, 0, XCD_BAR_WORDS * 4, stream) != hipSuccess) { fprintf(stderr, "kernel_launch: memset failed\n"); return; }
    KArgs a{};
    for (int i = 0; i < 29; ++i) a.in[i] = (const float*)d_in[i];
    a.out = (float*)d_out; a.ws = (unsigned char*)d_ws;
    void* args[] = {&a};
    hipError_t e = hipLaunchCooperativeKernel((const void*)fwd_kernel, dim3(grid), dim3(NT), args, LDS_BYTES, stream);
    if (e != hipSuccess) fprintf(stderr, "cooperative launch failed: %s (grid %d)\n", hipGetErrorString(e), grid);
}
```
